# Optimizing an MI355X kernel written in HIP

```python
import math
import jax, jax.numpy as jnp
from jax import lax
import numpy as np

D_MODEL = 1024
BATCH = 8
SEQ = 2048
DEPTH = 4
DEC_BATCH = 128
DEC_SEQ = 1
PAST_LEN = 8192
PAGE_SIZE = 128

N_HEADS = 8
N_KV_HEADS = 2
GROUP = N_HEADS // N_KV_HEADS
HEAD_DIM = 64
WINDOW = 128
ATTN_BLOCK = 128
ROPE_THETA = 10000.0
DN_HEADS = 4
DN_DK = 128
DN_DV = 128
CONV_W = 4
DN_CHUNK = 64
D_FF = 2816
EPS = 1e-6

ATTN_Q = N_HEADS * HEAD_DIM
ATTN_KV = N_KV_HEADS * HEAD_DIM
DN_QK = DN_HEADS * DN_DK
DN_V = DN_HEADS * DN_DV
CONV_DIM = 2 * DN_QK + DN_V
SPLIT_SIZES = (ATTN_Q, ATTN_KV, ATTN_KV, CONV_DIM, DN_V, DN_HEADS, DN_HEADS, D_MODEL, D_MODEL)
IN_COLS = sum(SPLIT_SIZES)

kernel_name = "hybrid_swa_sink_gated_deltanet_macaron_step"


def rms_norm(x, w):
    xf = x.astype(jnp.float32)
    y = xf * lax.rsqrt(jnp.mean(xf * xf, axis=-1, keepdims=True) + EPS)
    return (y * w.astype(jnp.float32)).astype(x.dtype)


def l2_norm(x):
    return x * lax.rsqrt(jnp.sum(x * x, axis=-1, keepdims=True) + EPS)


def swiglu_ffn(x, w_gate_up, w_down):
    g, u = jnp.split(x @ w_gate_up, 2, axis=-1)
    return (jax.nn.silu(g) * u) @ w_down


def rope(x, pos):
    half = HEAD_DIM // 2
    inv = 1.0 / (ROPE_THETA ** (jnp.arange(half, dtype=jnp.float32) / half))
    ang = pos.astype(jnp.float32)[:, None] * inv[None, :]
    cos = jnp.cos(ang)[None, :, None, :]
    sin = jnp.sin(ang)[None, :, None, :]
    xf = x.astype(jnp.float32)
    x1, x2 = xf[..., :half], xf[..., half:]
    return jnp.concatenate([x1 * cos - x2 * sin, x2 * cos + x1 * sin], axis=-1).astype(x.dtype)


def split_in(p):
    idx = [int(i) for i in np.cumsum(SPLIT_SIZES)[:-1]]
    return jnp.split(p, idx, axis=-1)


def sink_attention(q, k, v, mask, sinks):
    s = jnp.einsum('bnqhgd,bnkhd->bnhgqk', q, k).astype(jnp.float32) / math.sqrt(HEAD_DIM)
    s = jnp.where(mask[None, :, None, None], s, -jnp.inf)
    sink = jnp.broadcast_to(sinks.astype(jnp.float32).reshape(N_KV_HEADS, GROUP)[None, None, :, :, None, None],
                            s.shape[:-1] + (1,))
    p = jax.nn.softmax(jnp.concatenate([s, sink], axis=-1), axis=-1)[..., :-1]
    return jnp.einsum('bnhgqk,bnkhd->bnqhgd', p.astype(v.dtype), v)


def swa_prompt(q, k, v, sinks):
    B, T = q.shape[:2]
    nb = T // ATTN_BLOCK
    qb = q.reshape(B, nb, ATTN_BLOCK, N_KV_HEADS, GROUP, HEAD_DIM)

    def band(x):
        xp = jnp.concatenate([jnp.zeros_like(x[:, :ATTN_BLOCK]), x], axis=1)
        xp = xp.reshape(B, nb + 1, ATTN_BLOCK, N_KV_HEADS, HEAD_DIM)
        return jnp.concatenate([xp[:, :-1], xp[:, 1:]], axis=2)

    kb, vb = band(k), band(v)
    a = jnp.arange(ATTN_BLOCK)[:, None]
    b = jnp.arange(2 * ATTN_BLOCK)[None, :]
    rel = ATTN_BLOCK + a - b
    in_band = (rel >= 0) & (rel <= WINDOW)
    valid = (jnp.arange(nb)[:, None, None] > 0) | (b[None] >= ATTN_BLOCK)
    mask = in_band[None] & valid
    o = sink_attention(qb, kb, vb, mask, sinks)
    return o.reshape(B, T, ATTN_Q)


def swa_sample(q, k, v, buf_k, buf_v, sinks):
    B, T = q.shape[:2]
    kc = jnp.concatenate([buf_k.astype(k.dtype), k], axis=1)
    vc = jnp.concatenate([buf_v.astype(v.dtype), v], axis=1)
    j = jnp.arange(T)[:, None]
    m = jnp.arange(WINDOW + T)[None, :]
    rel = WINDOW + j - m
    mask = ((rel >= 0) & (rel <= WINDOW))[None]
    o = sink_attention(q.reshape(B, 1, T, N_KV_HEADS, GROUP, HEAD_DIM), kc[:, None], vc[:, None], mask, sinks)
    return o.reshape(B, T, ATTN_Q), kc[:, -WINDOW:], vc[:, -WINDOW:]


def short_conv(x_raw, conv_buf, conv_w):
    T = x_raw.shape[1]
    xp = jnp.concatenate([conv_buf.astype(x_raw.dtype), x_raw], axis=1)
    y = xp[:, 0:T] * conv_w[0]
    for i in range(1, CONV_W):
        y = y + xp[:, i:i + T] * conv_w[i]
    return jax.nn.silu(y), xp[:, -(CONV_W - 1):]


def gdn_chunked(q, k, v, g, beta, S0):
    B, T, H, dk = q.shape
    dv = v.shape[-1]
    C = DN_CHUNK
    n = T // C

    def chunks(x):
        return x.reshape((B, n, C, H) + x.shape[3:]).swapaxes(2, 3)

    qc, kc, vc, gc, bc = chunks(q), chunks(k), chunks(v), chunks(g), chunks(beta)
    G = jnp.cumsum(gc, axis=-1)
    i = jnp.arange(C)[:, None]
    j = jnp.arange(C)[None, :]
    decay = jnp.exp(jnp.where(j <= i, G[..., :, None] - G[..., None, :], -jnp.inf))
    kk = jnp.einsum('bnhid,bnhjd->bnhij', kc, kc)
    A = jnp.where(j < i, bc[..., :, None] * kk * decay, 0.0)
    lhs = jnp.eye(C, dtype=A.dtype) + A
    rhs = jnp.concatenate([vc * bc[..., None], kc * (bc * jnp.exp(G))[..., None]], axis=-1)
    sol = lax.linalg.triangular_solve(lhs, rhs, left_side=True, lower=True, unit_diagonal=True)
    u_base, w = sol[..., :dv], sol[..., dv:]
    qk = jnp.einsum('bnhid,bnhjd->bnhij', qc, kc) * decay
    q_dec = qc * jnp.exp(G)[..., None]
    k_dec = kc * jnp.exp(G[..., -1:] - G)[..., None]
    g_last = jnp.exp(G[..., -1])

    def step(S, xs):
        u_b, w_c, qk_c, qd_c, kd_c, gl_c = xs
        u = u_b - jnp.einsum('bhcd,bhde->bhce', w_c, S)
        o = jnp.einsum('bhcd,bhde->bhce', qd_c, S) + jnp.einsum('bhij,bhje->bhie', qk_c, u)
        S = S * gl_c[..., None, None] + jnp.einsum('bhcd,bhce->bhde', kd_c, u)
        return S, o

    xs = tuple(x.swapaxes(0, 1) for x in (u_base, w, qk, q_dec, k_dec, g_last))
    S, o = lax.scan(step, S0, xs)
    return o.transpose(1, 0, 3, 2, 4).reshape(B, T, H, dv), S


def gdn_recurrent(q, k, v, g, beta, S0):
    def step(S, xs):
        q_t, k_t, v_t, g_t, b_t = xs
        S = S * jnp.exp(g_t)[..., None, None]
        pred = jnp.einsum('bhd,bhde->bhe', k_t, S)
        S = S + jnp.einsum('bhd,bhe->bhde', k_t, b_t[..., None] * (v_t - pred))
        return S, jnp.einsum('bhd,bhde->bhe', q_t, S)

    xs = tuple(x.swapaxes(0, 1) for x in (q, k, v, g, beta))
    S, o = lax.scan(step, S0, xs)
    return o.swapaxes(0, 1), S


def hybrid_layer(x, pos, lw, buf_k, buf_v, dn_state, conv_buf, is_prompt):
    B, T, _ = x.shape
    f32 = jnp.float32
    h = x + 0.5 * swiglu_ffn(rms_norm(x, lw['ffn1_norm']), lw['ffn1_w_gate_up'], lw['ffn1_w_down'])
    u = rms_norm(h, lw['mix_norm'])
    aq, ak, av, dn_raw, dn_z, dn_b, dn_a, gate_a, gate_d = split_in(u @ lw['w_in'])

    q = rope(rms_norm(aq.reshape(B, T, N_HEADS, HEAD_DIM), lw['q_norm']), pos)
    k = rope(rms_norm(ak.reshape(B, T, N_KV_HEADS, HEAD_DIM), lw['k_norm']), pos)
    v = av.reshape(B, T, N_KV_HEADS, HEAD_DIM)
    if is_prompt:
        o_a = swa_prompt(q, k, v, lw['attn_sinks'])
        new_k, new_v = k[:, -WINDOW:], v[:, -WINDOW:]
    else:
        o_a, new_k, new_v = swa_sample(q, k, v, buf_k, buf_v, lw['attn_sinks'])

    if is_prompt:
        conv_buf = jnp.zeros((B, CONV_W - 1, CONV_DIM), dn_raw.dtype)
    qkv, new_conv = short_conv(dn_raw, conv_buf, lw['conv_w'])
    dq, dk, dvv = jnp.split(qkv, [DN_QK, 2 * DN_QK], axis=-1)
    dq = l2_norm(dq.reshape(B, T, DN_HEADS, DN_DK).astype(f32)) * (DN_DK ** -0.5)
    dk = l2_norm(dk.reshape(B, T, DN_HEADS, DN_DK).astype(f32))
    dvv = dvv.reshape(B, T, DN_HEADS, DN_DV).astype(f32)
    beta = jax.nn.sigmoid(dn_b.astype(f32))
    g = -jnp.exp(lw['dn_A_log'].astype(f32)) * jax.nn.softplus(dn_a.astype(f32) + lw['dn_dt_bias'].astype(f32))
    if is_prompt:
        S0 = jnp.zeros((B, DN_HEADS, DN_DK, DN_DV), f32)
        o_d, S = gdn_chunked(dq, dk, dvv, g, beta, S0)
    else:
        o_d, S = gdn_recurrent(dq, dk, dvv, g, beta, dn_state.astype(f32))
    o_d = rms_norm(o_d, lw['dn_out_norm']) * jax.nn.silu(dn_z.reshape(B, T, DN_HEADS, DN_DV).astype(f32))
    o_d = o_d.reshape(B, T, DN_V).astype(x.dtype)

    br_a = o_a @ lw['w_attn_o']
    br_d = o_d @ lw['w_dn_o']
    h = h + (jax.nn.sigmoid(gate_a) * br_a + jax.nn.sigmoid(gate_d) * br_d) @ lw['w_out']
    y = h + 0.5 * swiglu_ffn(rms_norm(h, lw['ffn2_norm']), lw['ffn2_w_gate_up'], lw['ffn2_w_down'])
    return y, new_k, new_v, S.astype(x.dtype), new_conv


def setup_inputs(seed: int = 0) -> dict:
    key = jax.random.key(seed)
    ks = jax.random.split(key, 24)
    nrm = jax.random.normal
    f32 = jnp.float32
    dt = jnp.exp(jax.random.uniform(ks[14], (DEPTH, DN_HEADS), minval=math.log(1e-3), maxval=math.log(1e-1)))
    return {
        "x_prompt": nrm(ks[0], (BATCH, SEQ, D_MODEL), f32),
        "x_sample": nrm(ks[1], (DEC_BATCH, DEC_SEQ, D_MODEL), f32),
        "cache_swa_k": nrm(ks[2], (DEPTH, DEC_BATCH, WINDOW, N_KV_HEADS, HEAD_DIM), f32),
        "cache_swa_v": nrm(ks[3], (DEPTH, DEC_BATCH, WINDOW, N_KV_HEADS, HEAD_DIM), f32),
        "state_dn": 0.05 * nrm(ks[4], (DEPTH, DEC_BATCH, DN_HEADS, DN_DK, DN_DV), f32),
        "state_conv": nrm(ks[5], (DEPTH, DEC_BATCH, CONV_W - 1, CONV_DIM), f32),
        "ffn1_norm": 1.0 + 0.02 * nrm(ks[6], (DEPTH, D_MODEL), f32),
        "ffn1_w_gate_up": nrm(ks[7], (DEPTH, D_MODEL, 2 * D_FF), f32) * D_MODEL ** -0.5,
        "ffn1_w_down": nrm(ks[8], (DEPTH, D_FF, D_MODEL), f32) * D_FF ** -0.5,
        "mix_norm": 1.0 + 0.02 * nrm(ks[9], (DEPTH, D_MODEL), f32),
        "w_in": nrm(ks[10], (DEPTH, D_MODEL, IN_COLS), f32) * D_MODEL ** -0.5,
        "q_norm": 1.0 + 0.02 * nrm(ks[11], (DEPTH, HEAD_DIM), f32),
        "k_norm": 1.0 + 0.02 * nrm(ks[12], (DEPTH, HEAD_DIM), f32),
        "attn_sinks": 0.5 * nrm(ks[13], (DEPTH, N_HEADS), f32),
        "conv_w": nrm(ks[15], (DEPTH, CONV_W, CONV_DIM), f32) * CONV_W ** -0.5,
        "dn_A_log": jnp.log(jax.random.uniform(ks[16], (DEPTH, DN_HEADS), minval=1.0, maxval=16.0)),
        "dn_dt_bias": dt + jnp.log(-jnp.expm1(-dt)),
        "dn_out_norm": 1.0 + 0.02 * nrm(ks[17], (DEPTH, DN_DV), f32),
        "w_attn_o": nrm(ks[18], (DEPTH, ATTN_Q, D_MODEL), f32) * ATTN_Q ** -0.5,
        "w_dn_o": nrm(ks[19], (DEPTH, DN_V, D_MODEL), f32) * DN_V ** -0.5,
        "w_out": nrm(ks[20], (DEPTH, D_MODEL, D_MODEL), f32) * D_MODEL ** -0.5,
        "ffn2_norm": 1.0 + 0.02 * nrm(ks[21], (DEPTH, D_MODEL), f32),
        "ffn2_w_gate_up": nrm(ks[22], (DEPTH, D_MODEL, 2 * D_FF), f32) * D_MODEL ** -0.5,
        "ffn2_w_down": nrm(ks[23], (DEPTH, D_FF, D_MODEL), f32) * D_FF ** -0.5,
    }


def reference(x_prompt, x_sample, cache_swa_k, cache_swa_v, state_dn, state_conv,
              ffn1_norm, ffn1_w_gate_up, ffn1_w_down, mix_norm, w_in, q_norm, k_norm, attn_sinks,
              conv_w, dn_A_log, dn_dt_bias, dn_out_norm, w_attn_o, w_dn_o, w_out,
              ffn2_norm, ffn2_w_gate_up, ffn2_w_down):
    pos_p = jnp.arange(x_prompt.shape[1])
    pos_s = PAST_LEN + jnp.arange(x_sample.shape[1])
    yp, ys = x_prompt, x_sample
    kp_l, vp_l, sp_l, cp_l = [], [], [], []
    ks_l, vs_l, ss_l, cs_l = [], [], [], []
    for l in range(DEPTH):
        lw = dict(ffn1_norm=ffn1_norm[l], ffn1_w_gate_up=ffn1_w_gate_up[l], ffn1_w_down=ffn1_w_down[l],
                  mix_norm=mix_norm[l], w_in=w_in[l], q_norm=q_norm[l], k_norm=k_norm[l],
                  attn_sinks=attn_sinks[l], conv_w=conv_w[l], dn_A_log=dn_A_log[l],
                  dn_dt_bias=dn_dt_bias[l], dn_out_norm=dn_out_norm[l], w_attn_o=w_attn_o[l],
                  w_dn_o=w_dn_o[l], w_out=w_out[l], ffn2_norm=ffn2_norm[l],
                  ffn2_w_gate_up=ffn2_w_gate_up[l], ffn2_w_down=ffn2_w_down[l])
        yp, kp, vp, sp, cp = hybrid_layer(yp, pos_p, lw, None, None, None, None, True)
        ys, kss, vss, sss, css = hybrid_layer(ys, pos_s, lw, cache_swa_k[l], cache_swa_v[l],
                                              state_dn[l], state_conv[l], False)
        kp_l.append(kp); vp_l.append(vp); sp_l.append(sp); cp_l.append(cp)
        ks_l.append(kss); vs_l.append(vss); ss_l.append(sss); cs_l.append(css)
    return (yp, ys,
            jnp.stack(kp_l), jnp.stack(vp_l), jnp.stack(sp_l), jnp.stack(cp_l),
            jnp.stack(ks_l), jnp.stack(vs_l), jnp.stack(ss_l), jnp.stack(cs_l))
```

```cpp
#include <hip/hip_runtime.h>
#include <hip/hip_cooperative_groups.h>
#include <cstdio>
#include <cstdint>
namespace cg = cooperative_groups;
#ifndef SUBREP
#define SUBREP 0
#endif

#define LAS __attribute__((address_space(3)))
typedef unsigned short bf16_t;
typedef short bf16x8 __attribute__((ext_vector_type(8)));
typedef float f32x4 __attribute__((ext_vector_type(4)));
typedef unsigned u32x4 __attribute__((ext_vector_type(4)));
typedef unsigned u32x2 __attribute__((ext_vector_type(2)));

constexpr int TP = 16384, TS = 128, TT = TP + TS, MP = 16640;
constexpr int DM = 1024, FF = 2816, NIN = 4864, NINSRC = 4872, DEPTH = 4;
constexpr float EPS = 1e-6f;
constexpr int PC_Q = 0, PC_K = 512, PC_V = 640, PC_RAW = 768, PC_Z = 2304, PC_GA = 2816, PC_GD = 3840;
constexpr size_t O_YP = 0, O_YS = 16777216, O_KP = 16908288, O_VP = 17432576, O_DNP = 17956864, O_CVP = 20054016,
                 O_KS = 20201472, O_VS = 28590080, O_DNS = 36978688, O_CVS = 70533120;
constexpr size_t WL_GU1 = 0, WL_DN1 = WL_GU1 + (size_t)5632 * 1024, WL_WIN = WL_DN1 + (size_t)1024 * 2816, WL_AO = WL_WIN + (size_t)NIN * 1024,
                 WL_DO = WL_AO + (size_t)1024 * 512, WL_WO = WL_DO + (size_t)1024 * 512, WL_GU2 = WL_WO + (size_t)1024 * 1024,
                 WL_DN2 = WL_GU2 + (size_t)5632 * 1024, WL_END = WL_DN2 + (size_t)1024 * 2816;
constexpr size_t MiB = 1u << 20;
constexpr size_t WS_ROPE = 0;
constexpr size_t WS_BG = 1 * MiB;
constexpr size_t WS_GL = 2 * MiB;
constexpr size_t WS_BAR = 2 * MiB + 65536;
constexpr size_t WS_W = 3 * MiB;
constexpr size_t WS_H = WS_W + ((WL_END * 2 * DEPTH + MiB - 1) / MiB) * MiB;
constexpr size_t WS_XN = WS_H + (size_t)MP * DM * 4;
constexpr size_t WS_ACT = WS_XN + (size_t)MP * DM * 2;
constexpr size_t WS_P = WS_ACT + (size_t)MP * FF * 2;
constexpr size_t WS_OA = WS_P + (size_t)MP * NIN * 2;
constexpr size_t WS_OD = WS_OA + (size_t)MP * 512 * 2;
constexpr size_t WS_ODF = WS_OD + (size_t)MP * 512 * 2;
constexpr size_t WS_PART = WS_ODF + (size_t)TP * 512 * 4;
constexpr size_t WS_END = WS_PART + (size_t)11 * TS * DM * 4;
constexpr size_t WS_UT = WS_ACT;
constexpr size_t WS_WN = WS_UT + (size_t)1024 * 8192 * 4;
constexpr size_t WS_QD = WS_WN + (size_t)1024 * 8192 * 2;
constexpr size_t WS_KDT = WS_QD + (size_t)1024 * 8192 * 2;
constexpr size_t WS_QK = WS_KDT + (size_t)1024 * 8192 * 2;
static_assert(WS_QK + (size_t)1024 * 4096 * 2 <= WS_P, "deltanet overlay fits in ACT");
static_assert((size_t)MP * DM * 4 <= (size_t)MP * FF * 2, "TMP fits in ACT");

constexpr int LDS_BYTES = 147456;

struct Params {
    const float* x_prompt; const float* x_sample; const float* cache_k; const float* cache_v; const float* state_dn; const float* state_conv;
    const float* ffn1_norm; const float* ffn1_gu; const float* ffn1_dn; const float* mix_norm; const float* w_in; const float* q_norm; const float* k_norm;
    const float* sinks; const float* conv_w; const float* A_log; const float* dt_bias; const float* dn_out_norm; const float* w_attn_o; const float* w_dn_o;
    const float* w_out; const float* ffn2_norm; const float* ffn2_gu; const float* ffn2_dn;
    float* out; unsigned char* ws;
};

__device__ __forceinline__ unsigned pk2(float lo, float hi);
__device__ __forceinline__ unsigned f2bf(float f) { return pk2(f, 0.f) & 0xffffu; }
typedef float f32x2_t __attribute__((ext_vector_type(2)));
typedef __bf16 bf16x2_t __attribute__((ext_vector_type(2)));
__device__ __forceinline__ unsigned pk2(float lo, float hi) { const f32x2_t v = {lo, hi}; const bf16x2_t b = __builtin_convertvector(v, bf16x2_t); return __builtin_bit_cast(unsigned, b); }
__device__ __forceinline__ float bflo(unsigned w) { return __uint_as_float(w << 16); }
__device__ __forceinline__ float bfhi(unsigned w) { return __uint_as_float(w & 0xffff0000u); }
__device__ __forceinline__ float bf1(bf16_t v) { return __uint_as_float(((unsigned)v) << 16); }
__device__ __forceinline__ float sigmoidf_(float x) { return __builtin_amdgcn_rcpf(1.0f + __expf(-x)); }
__device__ __forceinline__ float siluf_(float x) { return x * __builtin_amdgcn_rcpf(1.0f + __expf(-x)); }
__device__ __forceinline__ float softplusf_(float x) { return x > 20.f ? x : log1pf(__expf(x)); }

namespace pg8 {
constexpr int BM = 256, BK = 64, HALF = 128, HTB = HALF * BK * 2, NXCD = 8, WGM = 8;
__host__ __device__ __forceinline__ int lds_byte(int r, int c) { const int st = (r >> 4) * 2 + (c >> 5), rr = r & 15, cc = c & 31, ob = rr * 64 + cc * 2; return st * 1024 + (ob ^ (((ob >> 9) & 1) << 5)); }
__host__ __device__ __forceinline__ void stage_rc(int b, int& R, int& C) { const int st = b / 1024, sb = b % 1024, swz = sb ^ (((sb >> 9) & 1) << 5); R = (st >> 1) * 16 + swz / 64; C = (st & 1) * 32 + (swz % 64) / 2; }
struct Unit { int pm, pn, k0, nt; };
struct Gemm { const bf16_t* A; const bf16_t* Bt; int M, N, K; };
struct StaticOrder {
    int nM, nN, nwg, G, c, ntMain, extraBase, nExtra, extraNt;
    __device__ void init(int N, int K, int G_, int c_, int extraBase_, int nExtra_, int extraNt_) { nM = 64; nN = N / BM; nwg = nM * nN; G = G_; c = c_; ntMain = K / BK; extraBase = extraBase_; nExtra = nExtra_; extraNt = extraNt_; }
    __device__ bool next(int i, Unit& u) const {
        const long L = (long)i * G + c;
        if (L < nwg) {
            int wgid = (int)L; { const int q = nwg / NXCD, r = nwg % NXCD, xcd = wgid % NXCD, off = wgid / NXCD; wgid = (xcd < r ? xcd * (q + 1) : r * (q + 1) + (xcd - r) * q) + off; }
            const int nig = WGM * nN, gid = wgid / nig, fm = gid * WGM, gsz = (nM - fm) < WGM ? (nM - fm) : WGM;
            u.pm = fm + ((wgid % nig) % gsz); u.pn = (wgid % nig) / gsz; u.k0 = 0; u.nt = ntMain; return true;
        }
        const int nc = (nwg - c + G - 1) / G, j = c - extraBase;
        if (i == nc && j >= 0 && j < nExtra) { u.pm = 64; u.pn = j % nN; u.k0 = (j / nN) * extraNt; u.nt = extraNt; return true; }
        return false;
    }
};
template <class Epi, bool HOOK = false>
__device__ __forceinline__ void gemm_phase(LAS unsigned char* lds, const Gemm g, const StaticOrder& S, const Epi& E, const int tid) {
    const int wid = __builtin_amdgcn_readfirstlane(tid >> 6), lane = tid & 63, wr = wid >> 2, wc = wid & 3, fr = lane & 15, fq = lane >> 4;
    const int K = g.K;
    unsigned voffA[2];
#pragma unroll
    for (int i = 0; i < 2; ++i) { int R, C; stage_rc(tid * 16 + i * 8192, R, C); voffA[i] = (unsigned)(R * K + C) * 2u; }
    const size_t kstep = (size_t)(BK * 2);
    const size_t hstep = (size_t)HALF * K * 2;
    const size_t tstep = 2 * hstep;
    const unsigned ldsw = (unsigned)wid * 1024u;
    const int aoff = lds_byte(wr * 64 + fr, fq * 8), boff = lds_byte(wc * 32 + fr, fq * 8);
#define PG8_SA(b, h) (((b) * 2 + (h)) * HTB)
#define PG8_SB(b, h) ((4 + (b) * 2 + (h)) * HTB)
#define PG8_STAGE(bufoff, gbase) do { _Pragma("unroll") for (int _i = 0; _i < 2; ++_i) \
        __builtin_amdgcn_global_load_lds((const unsigned*)((const char*)(gbase) + voffA[_i]), (LAS unsigned*)(lds + (bufoff) + ldsw + _i * 8192), 16, 0, 0); } while (0)
#define PG8_LDA(dst, b, h) do { _Pragma("unroll") for (int m = 0; m < 4; ++m) _Pragma("unroll") for (int k = 0; k < 2; ++k) dst[m][k] = *(const LAS bf16x8*)(lds + PG8_SA(b, h) + aoff + m * 2048 + k * 1024); } while (0)
#define PG8_LDB(dst, b, h) do { _Pragma("unroll") for (int n = 0; n < 2; ++n) _Pragma("unroll") for (int k = 0; k < 2; ++k) dst[n][k] = *(const LAS bf16x8*)(lds + PG8_SB(b, h) + boff + n * 2048 + k * 1024); } while (0)
#define PG8_MMA(ai, bj, At, Bt) do { __builtin_amdgcn_s_setprio(1); _Pragma("unroll") for (int m = 0; m < 4; ++m) _Pragma("unroll") for (int n = 0; n < 2; ++n) _Pragma("unroll") for (int k = 0; k < 2; ++k) \
        acc[ai][bj][m][n] = __builtin_amdgcn_mfma_f32_16x16x32_bf16(Bt[n][k], At[m][k], acc[ai][bj][m][n], 0, 0, 0); __builtin_amdgcn_s_setprio(0); } while (0)
#define PG8_WAIT_V(n) asm volatile("s_waitcnt vmcnt(" #n ")" ::: "memory")
#define PG8_WAIT_L(n) asm volatile("s_waitcnt lgkmcnt(" #n ")" ::: "memory")
#define PG8_BAR __builtin_amdgcn_s_barrier()
#define PG8_SCHED __builtin_amdgcn_sched_barrier(0)
    Unit cur, nxt; int ui = 0;
    if (!S.next(0, cur)) return;
    f32x4 acc[2][2][4][2];
#pragma unroll
    for (int a = 0; a < 2; ++a)
#pragma unroll
        for (int b = 0; b < 2; ++b)
#pragma unroll
            for (int m = 0; m < 4; ++m)
#pragma unroll
                for (int n = 0; n < 2; ++n) acc[a][b][m][n] = (f32x4){0.f, 0.f, 0.f, 0.f};
    bf16x8 At[4][2], B0[2][2], B1[2][2];
    const char* cA = (const char*)g.A + (size_t)cur.pm * tstep + (size_t)cur.k0 * kstep; const char* cB = (const char*)g.Bt + (size_t)cur.pn * tstep + (size_t)cur.k0 * kstep;
    PG8_STAGE(PG8_SB(0, 0), cB); PG8_STAGE(PG8_SB(0, 1), cB + hstep); PG8_STAGE(PG8_SA(0, 0), cA); PG8_STAGE(PG8_SA(0, 1), cA + hstep);
    if (wr == 1) PG8_BAR;
    PG8_WAIT_V(2); PG8_BAR;
    PG8_STAGE(PG8_SB(1, 0), cB + kstep); PG8_STAGE(PG8_SA(1, 0), cA + kstep); PG8_STAGE(PG8_SB(1, 1), cB + hstep + kstep);
    PG8_WAIT_V(6); PG8_BAR;
    for (;;) {
        const bool has_next = S.next(ui + 1, nxt);
        const char* nA = has_next ? (const char*)g.A + (size_t)nxt.pm * tstep + (size_t)nxt.k0 * kstep : cA; const char* nB = has_next ? (const char*)g.Bt + (size_t)nxt.pn * tstep + (size_t)nxt.k0 * kstep : cB;
        const int nt = cur.nt;
        for (int t = 0; t < nt; t += 2) {
            const bool last = (t == nt - 2);
            if constexpr (HOOK) if (t == 8) { int fr2 = fr, fq2 = fq; asm volatile("" : "+v"(fr2), "+v"(fq2)); E.mid(acc, cur, wr, wc, fr2, fq2); }
            const char* a1 = cA + (size_t)(t + 1) * kstep;
            const char* a2 = last ? nA : cA + (size_t)(t + 2) * kstep; const char* b2 = last ? nB : cB + (size_t)(t + 2) * kstep;
            const char* a3 = a2 + kstep; const char* b3 = b2 + kstep;
            PG8_LDB(B0, 0, 0); PG8_LDB(B1, 0, 1); PG8_SCHED; PG8_LDA(At, 0, 0); PG8_STAGE(PG8_SA(1, 1), a1 + hstep);
            PG8_WAIT_V(8); PG8_WAIT_L(0); PG8_BAR; PG8_MMA(0, 0, At, B0); PG8_MMA(0, 1, At, B1); PG8_BAR; PG8_SCHED;
            PG8_LDA(At, 0, 1); PG8_STAGE(PG8_SB(0, 0), b2); PG8_STAGE(PG8_SB(0, 1), b2 + hstep); PG8_STAGE(PG8_SA(0, 0), a2);
            PG8_WAIT_V(8); PG8_WAIT_L(0); PG8_BAR; PG8_MMA(1, 0, At, B0); PG8_MMA(1, 1, At, B1); PG8_BAR; PG8_SCHED;
            PG8_LDB(B0, 1, 0); PG8_LDB(B1, 1, 1); PG8_SCHED; PG8_LDA(At, 1, 0); PG8_STAGE(PG8_SA(0, 1), a2 + hstep);
            PG8_WAIT_V(8); PG8_WAIT_L(0); PG8_BAR; PG8_MMA(0, 0, At, B0); PG8_MMA(0, 1, At, B1); PG8_BAR; PG8_SCHED;
            PG8_LDA(At, 1, 1); PG8_STAGE(PG8_SB(1, 0), b3); PG8_STAGE(PG8_SB(1, 1), b3 + hstep); PG8_STAGE(PG8_SA(1, 0), a3);
            PG8_WAIT_V(8); PG8_WAIT_L(0); PG8_BAR; PG8_MMA(1, 0, At, B0); PG8_MMA(1, 1, At, B1); PG8_BAR; PG8_SCHED;
        }
        if (wr == 0) PG8_BAR;
        { int fr2 = fr, fq2 = fq; asm volatile("" : "+v"(fr2), "+v"(fq2)); E(acc, cur, wr, wc, fr2, fq2); }
        if (!has_next) break;
#pragma unroll
        for (int a = 0; a < 2; ++a)
#pragma unroll
            for (int b = 0; b < 2; ++b)
#pragma unroll
                for (int m = 0; m < 4; ++m)
#pragma unroll
                    for (int n = 0; n < 2; ++n) acc[a][b][m][n] = (f32x4){0.f, 0.f, 0.f, 0.f};
        cur = nxt; cA = nA; cB = nB; ++ui;
        if (wr == 1) PG8_BAR;
    }
    PG8_WAIT_V(0);
    PG8_BAR;
#undef PG8_SA
#undef PG8_SB
#undef PG8_STAGE
#undef PG8_LDA
#undef PG8_LDB
#undef PG8_MMA
#undef PG8_WAIT_V
#undef PG8_WAIT_L
#undef PG8_BAR
#undef PG8_SCHED
}
}

typedef f32x4 AccT[2][2][4][2];

struct EpiSwiglu {
    bf16_t* act;
    __device__ __forceinline__ void operator()(const AccT& acc, const pg8::Unit& u, int wr, int wc, int fr, int fq) const {
#pragma unroll
        for (int ai = 0; ai < 2; ++ai)
#pragma unroll
            for (int m = 0; m < 4; ++m) {
                const int row = u.pm * 256 + ai * 128 + wr * 64 + m * 16 + fr;
                bf16_t* rp = act + (size_t)row * FF + u.pn * 128 + wc * 32 + fq * 8;
                const f32x4 g0 = acc[ai][0][m][0], u0 = acc[ai][1][m][0], g1 = acc[ai][0][m][1], u1 = acc[ai][1][m][1];
                u32x4 w; w.x = pk2(siluf_(g0[0]) * u0[0], siluf_(g0[1]) * u0[1]); w.y = pk2(siluf_(g0[2]) * u0[2], siluf_(g0[3]) * u0[3]);
                w.z = pk2(siluf_(g1[0]) * u1[0], siluf_(g1[1]) * u1[1]); w.w = pk2(siluf_(g1[2]) * u1[2], siluf_(g1[3]) * u1[3]);
                *(u32x4*)rp = w;
            }
    }
};
struct EpiResid {
    const float* baseP; float* outP; float scale; float* part;
    __device__ __forceinline__ void operator()(const AccT& acc, const pg8::Unit& u, int wr, int wc, int fr, int fq) const {
        if (u.pm == 64) {
            float* pp = part + (size_t)(u.k0 / u.nt) * (TS * DM);
#pragma unroll
            for (int m = 0; m < 4; ++m) {
                const int r = wr * 64 + m * 16 + fr;
#pragma unroll
                for (int bj = 0; bj < 2; ++bj)
#pragma unroll
                    for (int n = 0; n < 2; ++n) *(f32x4*)(pp + (size_t)r * DM + u.pn * 256 + bj * 128 + wc * 32 + fq * 8 + n * 4) = acc[0][bj][m][n];
            }
            return;
        }
#pragma unroll
        for (int ai = 0; ai < 2; ++ai)
#pragma unroll
            for (int m = 0; m < 4; ++m) {
                const int row = u.pm * 256 + ai * 128 + wr * 64 + m * 16 + fr;
                const float* b = baseP + (size_t)row * DM;
                float* o = outP + (size_t)row * DM;
#pragma unroll
                for (int bj = 0; bj < 2; ++bj)
#pragma unroll
                    for (int n = 0; n < 2; ++n) {
                        const int col = u.pn * 256 + bj * 128 + wc * 32 + fq * 8 + n * 4;
                        const f32x4 bv = *(const f32x4*)(b + col);
                        *(f32x4*)(o + col) = bv + scale * acc[ai][bj][m][n];
                    }
            }
    }
};
template <bool SECOND> struct EpiGate {
    const bf16_t* P; float* tmp; bf16_t* mrg;
    __device__ __forceinline__ void operator()(const AccT& acc, const pg8::Unit& u, int wr, int wc, int fr, int fq) const {
#pragma unroll
        for (int ai = 0; ai < 2; ++ai)
#pragma unroll
            for (int m = 0; m < 4; ++m) {
                const int row = u.pm * 256 + ai * 128 + wr * 64 + m * 16 + fr;
                if (row >= TT) continue;
#pragma unroll
                for (int bj = 0; bj < 2; ++bj)
#pragma unroll
                    for (int n = 0; n < 2; ++n) {
                        const int col = u.pn * 256 + bj * 128 + wc * 32 + fq * 8 + n * 4;
                        const u32x2 gw = *(const u32x2*)(P + (size_t)row * NIN + (SECOND ? PC_GD : PC_GA) + col);
                        const f32x4 a = acc[ai][bj][m][n];
                        f32x4 v; v[0] = sigmoidf_(bflo(gw.x)) * a[0]; v[1] = sigmoidf_(bfhi(gw.x)) * a[1]; v[2] = sigmoidf_(bflo(gw.y)) * a[2]; v[3] = sigmoidf_(bfhi(gw.y)) * a[3];
                        float* tp = tmp + (size_t)row * DM + col;
                        if (!SECOND) { *(f32x4*)tp = v; }
                        else { const f32x4 t = *(const f32x4*)tp; v = v + t; u32x2 w; w.x = pk2(v[0], v[1]); w.y = pk2(v[2], v[3]); *(u32x2*)(mrg + (size_t)row * DM + col) = w; }
                    }
            }
    }
};
struct EpiGateK {
    const bf16_t* P; bf16_t* mrg;
    __device__ __forceinline__ void mid(AccT& acc, const pg8::Unit& u, int wr, int wc, int fr, int fq) const {
#pragma unroll
        for (int ai = 0; ai < 2; ++ai)
#pragma unroll
            for (int m = 0; m < 4; ++m) {
                const int row = u.pm * 256 + ai * 128 + wr * 64 + m * 16 + fr;
                if (row >= TT) continue;
#pragma unroll
                for (int bj = 0; bj < 2; ++bj) {
                    const int col = u.pn * 256 + bj * 128 + wc * 32 + fq * 8;
                    const u32x4 ga = *(const u32x4*)(P + (size_t)row * NIN + PC_GA + col), gd = *(const u32x4*)(P + (size_t)row * NIN + PC_GD + col);
                    const unsigned gaw[4] = {ga.x, ga.y, ga.z, ga.w}, gdw[4] = {gd.x, gd.y, gd.z, gd.w};
#pragma unroll
                    for (int q = 0; q < 4; ++q) {
                        const float ea0 = __expf(-bflo(gaw[q])), ea1 = __expf(-bfhi(gaw[q]));
                        const float ed0 = __expf(fminf(-bflo(gdw[q]), 60.f)), ed1 = __expf(fminf(-bfhi(gdw[q]), 60.f));
                        const float r0 = (1.0f + ed0) * __builtin_amdgcn_rcpf(1.0f + ea0), r1 = (1.0f + ed1) * __builtin_amdgcn_rcpf(1.0f + ea1);
                        acc[ai][bj][m][q >> 1][(q & 1) * 2 + 0] *= r0; acc[ai][bj][m][q >> 1][(q & 1) * 2 + 1] *= r1;
                    }
                }
                __builtin_amdgcn_sched_barrier(0);
            }
    }
    __device__ __forceinline__ void operator()(const AccT& acc, const pg8::Unit& u, int wr, int wc, int fr, int fq) const {
#pragma unroll
        for (int ai = 0; ai < 2; ++ai)
#pragma unroll
            for (int m = 0; m < 4; ++m) {
                const int row = u.pm * 256 + ai * 128 + wr * 64 + m * 16 + fr;
                if (row >= TT) continue;
#pragma unroll
                for (int bj = 0; bj < 2; ++bj) {
                    const int col = u.pn * 256 + bj * 128 + wc * 32 + fq * 8;
                    const u32x4 gd = *(const u32x4*)(P + (size_t)row * NIN + PC_GD + col);
                    const unsigned gdw[4] = {gd.x, gd.y, gd.z, gd.w};
                    unsigned ow[4];
#pragma unroll
                    for (int q = 0; q < 4; ++q) {
                        const float s0 = __builtin_amdgcn_rcpf(1.0f + __expf(fminf(-bflo(gdw[q]), 60.f))), s1 = __builtin_amdgcn_rcpf(1.0f + __expf(fminf(-bfhi(gdw[q]), 60.f)));
                        ow[q] = pk2(acc[ai][bj][m][q >> 1][(q & 1) * 2 + 0] * s0, acc[ai][bj][m][q >> 1][(q & 1) * 2 + 1] * s1);
                    }
                    *(u32x4*)(mrg + (size_t)row * DM + col) = (u32x4){ow[0], ow[1], ow[2], ow[3]};
                }
            }
    }
};
struct EpiWin {
    bf16_t* P; const float* qnw; const float* knw; const float2* rope;
    __device__ __forceinline__ void operator()(const AccT& acc, const pg8::Unit& u, int wr, int wc, int fr, int fq) const {
        const int tile = u.pn;
        const bool headed = tile <= 1 || (tile == 2 && wc < 2), isq = tile <= 1;
        const float* nw = isq ? qnw : knw;
        const float sc = isq ? 0.125f : 1.0f;
#pragma unroll
        for (int ai = 0; ai < 2; ++ai)
#pragma unroll
            for (int m = 0; m < 4; ++m) {
                const int row = u.pm * 256 + ai * 128 + wr * 64 + m * 16 + fr;
                const bool valid = row < TT;
                bf16_t* prow = P + (size_t)row * NIN + tile * 256 + wc * 64;
                if (headed) {
                    float ss = 0.f;
#pragma unroll
                    for (int bj = 0; bj < 2; ++bj)
#pragma unroll
                        for (int n = 0; n < 2; ++n) { const f32x4 a = acc[ai][bj][m][n]; ss += a[0] * a[0] + a[1] * a[1] + a[2] * a[2] + a[3] * a[3]; }
                    ss += __shfl_xor(ss, 16); ss += __shfl_xor(ss, 32);
                    if (!valid) continue;
                    const float rs = rsqrtf(ss * (1.0f / 64.0f) + EPS);
                    const float2* rp = rope + (size_t)(row < TP ? (row & 2047) : 2048) * 32;
#pragma unroll
                    for (int n = 0; n < 2; ++n) {
                        const int i0 = fq * 8 + n * 4;
                        const f32x4 w1 = *(const f32x4*)(nw + i0), w2 = *(const f32x4*)(nw + 32 + i0);
                        f32x4 o1, o2;
#pragma unroll
                        for (int j = 0; j < 4; ++j) {
                            const float x1 = acc[ai][0][m][n][j] * rs * w1[j], x2 = acc[ai][1][m][n][j] * rs * w2[j];
                            const float2 cs = rp[i0 + j];
                            o1[j] = (x1 * cs.x - x2 * cs.y) * sc; o2[j] = (x2 * cs.x + x1 * cs.y) * sc;
                        }
                        u32x2 a, b; a.x = pk2(o1[0], o1[1]); a.y = pk2(o1[2], o1[3]); b.x = pk2(o2[0], o2[1]); b.y = pk2(o2[2], o2[3]);
                        *(u32x2*)(prow + i0) = a; *(u32x2*)(prow + 32 + i0) = b;
                    }
                } else {
                    if (!valid) continue;
#pragma unroll
                    for (int bj = 0; bj < 2; ++bj)
#pragma unroll
                        for (int n = 0; n < 2; ++n) {
                            const f32x4 a = acc[ai][bj][m][n];
                            u32x2 w; w.x = pk2(a[0], a[1]); w.y = pk2(a[2], a[3]);
                            *(u32x2*)(prow + bj * 32 + fq * 8 + n * 4) = w;
                        }
                }
            }
    }
};

typedef const __attribute__((address_space(4))) Params* PK;
struct Ctx { LAS unsigned char* lds; int tid, lane, wave, G, bid; };

__device__ __forceinline__ int src_col(int type, int n0) {
    if (type == 0) return n0;
    const int tile = n0 >> 8, p = n0 & 255;
    if (type == 1) return p < 128 ? tile * 128 + p : FF + tile * 128 + (p - 128);
    const int bj = p >> 7, wc = (p >> 5) & 3, c32 = p & 31; const int lg = tile * 256 + wc * 64 + bj * 32 + c32;
    return lg < PC_GA ? lg : lg + 8;
}
__device__ __forceinline__ void convert_weight(const Ctx& C, const float* src, int ld, int K, int N, int type, bf16_t* dst, int dld = 0, int koff = 0) {
    if (dld == 0) dld = K;
    LAS float* tile = (LAS float*)C.lds;
    const int nnt = N / 32, nitems = nnt * (K / 256);
    for (int it = C.bid; it < nitems; it += C.G) {
        const int ntile = it % nnt, kt = it / nnt, n0 = ntile * 32, k0 = kt * 256, s0 = src_col(type, n0);
        const int c4 = (C.tid & 7) * 4, kr = C.tid >> 3;
        f32x4 v[4];
#pragma unroll
        for (int p = 0; p < 4; ++p) v[p] = *(const f32x4*)(src + (size_t)(k0 + p * 64 + kr) * ld + s0 + c4);
#pragma unroll
        for (int p = 0; p < 4; ++p) { LAS float* tp = tile + (p * 64 + kr) * 33 + c4; tp[0] = v[p][0]; tp[1] = v[p][1]; tp[2] = v[p][2]; tp[3] = v[p][3]; }
        __syncthreads();
#pragma unroll
        for (int h2 = 0; h2 < 2; ++h2) {
            const int n = C.tid >> 4, ks = (C.tid & 15) * 8 + h2 * 128;
            const int ln = 8 * ((n >> 2) & 3) + 4 * (n >> 4) + (n & 3);
            u32x4 w;
            w.x = pk2(tile[(ks + 0) * 33 + ln], tile[(ks + 1) * 33 + ln]); w.y = pk2(tile[(ks + 2) * 33 + ln], tile[(ks + 3) * 33 + ln]);
            w.z = pk2(tile[(ks + 4) * 33 + ln], tile[(ks + 5) * 33 + ln]); w.w = pk2(tile[(ks + 6) * 33 + ln], tile[(ks + 7) * 33 + ln]);
            *(u32x4*)(dst + (size_t)(n0 + n) * dld + koff + k0 + ks) = w;
        }
        __syncthreads();
    }
}

__device__ __forceinline__ float wave_sum(float v) {
#pragma unroll
    for (int o = 1; o < 64; o <<= 1) v += __shfl_xor(v, o);
    return v;
}

template <bool WITH_BG>
__device__ __forceinline__ void norm_phase(const Ctx& C, const float* inP, const float* inS, const float* w, bf16_t* xn, const float* win_l, float* bg, const float* part, int np, float pscale, float* soutS) {
    float wb[16][8];
    if (WITH_BG) {
#pragma unroll
        for (int c = 0; c < 4; ++c)
#pragma unroll
            for (int e = 0; e < 4; ++e) {
                const float* wp = win_l + (size_t)(c * 256 + C.lane * 4 + e) * NINSRC + 2816;
                const f32x4 a = *(const f32x4*)wp, b = *(const f32x4*)(wp + 4);
                wb[c * 4 + e][0] = a[0]; wb[c * 4 + e][1] = a[1]; wb[c * 4 + e][2] = a[2]; wb[c * 4 + e][3] = a[3];
                wb[c * 4 + e][4] = b[0]; wb[c * 4 + e][5] = b[1]; wb[c * 4 + e][6] = b[2]; wb[c * 4 + e][7] = b[3];
            }
    }
    f32x4 nv[4];
    { const int row = C.bid * 8 + C.wave;
      if (row < TT) { const float* x = row < TP ? inP + (size_t)row * DM : inS + (size_t)(row - TP) * DM;
#pragma unroll
        for (int c = 0; c < 4; ++c) nv[c] = *(const f32x4*)(x + c * 256 + C.lane * 4); } }
    for (int row = C.bid * 8 + C.wave; row < TT; row += C.G * 8) {
        f32x4 v[4]; float ss = 0.f;
#pragma unroll
        for (int c = 0; c < 4; ++c) v[c] = nv[c];
        { const int r2 = row + C.G * 8;
          if (r2 < TT) { const float* x2 = r2 < TP ? inP + (size_t)r2 * DM : inS + (size_t)(r2 - TP) * DM;
#pragma unroll
            for (int c = 0; c < 4; ++c) nv[c] = *(const f32x4*)(x2 + c * 256 + C.lane * 4); } }
        if (row >= TP && np > 0) {
            f32x4 a[4];
#pragma unroll
            for (int c = 0; c < 4; ++c) a[c] = (f32x4){0.f, 0.f, 0.f, 0.f};
            for (int i = 0; i < np; ++i) {
                const float* pp = part + ((size_t)i * TS + (row - TP)) * DM + C.lane * 4;
#pragma unroll
                for (int c = 0; c < 4; ++c) a[c] += *(const f32x4*)(pp + c * 256);
            }
#pragma unroll
            for (int c = 0; c < 4; ++c) { v[c] += pscale * a[c]; *(f32x4*)(soutS + (size_t)(row - TP) * DM + c * 256 + C.lane * 4) = v[c]; }
        }
#pragma unroll
        for (int c = 0; c < 4; ++c) ss += v[c][0] * v[c][0] + v[c][1] * v[c][1] + v[c][2] * v[c][2] + v[c][3] * v[c][3];
        ss = wave_sum(ss);
        const float rs = rsqrtf(ss * (1.0f / 1024.0f) + EPS);
        float d[8];
        if (WITH_BG) {
#pragma unroll
            for (int q = 0; q < 8; ++q) d[q] = 0.f;
        }
#pragma unroll
        for (int c = 0; c < 4; ++c) {
            const f32x4 wv = *(const f32x4*)(w + c * 256 + C.lane * 4);
            f32x4 y = v[c] * rs * wv;
            u32x2 o; o.x = pk2(y[0], y[1]); o.y = pk2(y[2], y[3]);
            *(u32x2*)(xn + (size_t)row * DM + c * 256 + C.lane * 4) = o;
            if (WITH_BG) {
#pragma unroll
                for (int e = 0; e < 4; ++e)
#pragma unroll
                    for (int q = 0; q < 8; ++q) d[q] += y[e] * wb[c * 4 + e][q];
            }
        }
        if (WITH_BG) {
#pragma unroll
            for (int q = 0; q < 8; ++q) d[q] = wave_sum(d[q]);
            if (C.lane == 0) { *(f32x4*)(bg + (size_t)row * 8) = (f32x4){d[0], d[1], d[2], d[3]}; *(f32x4*)(bg + (size_t)row * 8 + 4) = (f32x4){d[4], d[5], d[6], d[7]}; }
        }
    }
}

__device__ __forceinline__ void finalize_od(const Ctx& C, const float* odf, const bf16_t* P, const float* onw, bf16_t* od) {
    const int e0 = (C.lane & 15) * 8;
    const f32x4 w0 = *(const f32x4*)(onw + e0), w1 = *(const f32x4*)(onw + e0 + 4);
    f32x4 na, nb; u32x4 nz;
    { const int row = C.bid * 8 + C.wave;
      if (row < TP) { const float* op = odf + (size_t)row * 512 + C.lane * 8; na = *(const f32x4*)op; nb = *(const f32x4*)(op + 4); nz = *(const u32x4*)(P + (size_t)row * NIN + PC_Z + C.lane * 8); } }
    for (int row = C.bid * 8 + C.wave; row < TP; row += C.G * 8) {
        const f32x4 a = na, b = nb; const u32x4 z = nz;
        { const int r2 = row + C.G * 8;
          if (r2 < TP) { const float* op = odf + (size_t)r2 * 512 + C.lane * 8; na = *(const f32x4*)op; nb = *(const f32x4*)(op + 4); nz = *(const u32x4*)(P + (size_t)r2 * NIN + PC_Z + C.lane * 8); } }
        float ss = a[0] * a[0] + a[1] * a[1] + a[2] * a[2] + a[3] * a[3] + b[0] * b[0] + b[1] * b[1] + b[2] * b[2] + b[3] * b[3];
        ss += __shfl_xor(ss, 1); ss += __shfl_xor(ss, 2); ss += __shfl_xor(ss, 4); ss += __shfl_xor(ss, 8);
        const float rs = rsqrtf(ss * (1.0f / 128.0f) + EPS);
        u32x4 o;
        o.x = pk2(a[0] * rs * w0[0] * siluf_(bflo(z.x)), a[1] * rs * w0[1] * siluf_(bfhi(z.x)));
        o.y = pk2(a[2] * rs * w0[2] * siluf_(bflo(z.y)), a[3] * rs * w0[3] * siluf_(bfhi(z.y)));
        o.z = pk2(b[0] * rs * w1[0] * siluf_(bflo(z.z)), b[1] * rs * w1[1] * siluf_(bfhi(z.z)));
        o.w = pk2(b[2] * rs * w1[2] * siluf_(bflo(z.w)), b[3] * rs * w1[3] * siluf_(bfhi(z.w)));
        *(u32x4*)(od + (size_t)row * 1024 + 512 + C.lane * 8) = o;
    }
}

__device__ __forceinline__ void attn_prompt_unit(const Ctx& C, int unit, const bf16_t* P, const float* sinks_l, bf16_t* OA) {
    const int kvh = unit & 1, qb = (unit >> 1) & 15, b = unit >> 5;
    LAS unsigned char* Ks = C.lds;
    LAS unsigned char* Vt = C.lds + 36864;
    const int tok0 = b * 2048 + qb * 128 - 128;
    bf16x8 qfa[2][2][2];
    {
        const int g_ = C.wave >> 1, hq_ = C.wave & 1, h_ = kvh * 4 + g_, fr_ = C.lane & 15, fq_ = C.lane >> 4;
#pragma unroll
        for (int it = 0; it < 2; ++it)
#pragma unroll
            for (int qt = 0; qt < 2; ++qt)
#pragma unroll
                for (int kk = 0; kk < 2; ++kk)
                    qfa[it][qt][kk] = *(const bf16x8*)(P + (size_t)(b * 2048 + qb * 128 + hq_ * 64 + it * 32 + qt * 16 + fr_) * NIN + PC_Q + h_ * 64 + kk * 32 + fq_ * 8);
    }
#pragma unroll
    for (int p = 0; p < 4; ++p) {
        const int id = C.tid + p * 512, r = id >> 3, ch = id & 7;
        const bool ok = (qb > 0) || (r >= 128);
        u32x4 kv = (u32x4){0u, 0u, 0u, 0u}, vv = (u32x4){0u, 0u, 0u, 0u};
        if (ok) { const bf16_t* rp = P + (size_t)(tok0 + r) * NIN; kv = *(const u32x4*)(rp + PC_K + kvh * 64 + ch * 8); vv = *(const u32x4*)(rp + PC_V + kvh * 64 + ch * 8); }
        *(LAS u32x4*)(Ks + r * 144 + ch * 16) = kv;
        LAS bf16_t* vt = (LAS bf16_t*)(Vt + (ch * 8) * 528 + r * 2);
        vt[0 * 264] = (bf16_t)(vv.x & 0xffff); vt[1 * 264] = (bf16_t)(vv.x >> 16); vt[2 * 264] = (bf16_t)(vv.y & 0xffff); vt[3 * 264] = (bf16_t)(vv.y >> 16);
        vt[4 * 264] = (bf16_t)(vv.z & 0xffff); vt[5 * 264] = (bf16_t)(vv.z >> 16); vt[6 * 264] = (bf16_t)(vv.w & 0xffff); vt[7 * 264] = (bf16_t)(vv.w >> 16);
    }
    __syncthreads();
    const int g = C.wave >> 1, hq = C.wave & 1, h = kvh * 4 + g, fr = C.lane & 15, fq = C.lane >> 4;
    const float sink = sinks_l[h];
#pragma unroll 1
    for (int it = 0; it < 2; ++it) {
        const int tq0 = hq * 64 + it * 32, jb0 = tq0;
        bf16x8 qf[2][2];
#pragma unroll
        for (int qt = 0; qt < 2; ++qt)
#pragma unroll
            for (int kk = 0; kk < 2; ++kk) qf[qt][kk] = it == 0 ? qfa[0][qt][kk] : qfa[1][qt][kk];
        f32x4 st[2][10];
#pragma unroll
        for (int kt = 0; kt < 10; ++kt) {
            st[0][kt] = (f32x4){0.f, 0.f, 0.f, 0.f}; st[1][kt] = (f32x4){0.f, 0.f, 0.f, 0.f};
#pragma unroll
            for (int kk = 0; kk < 2; ++kk) {
                const bf16x8 kf = *(const LAS bf16x8*)(Ks + (jb0 + kt * 16 + fr) * 144 + (kk * 32 + fq * 8) * 2);
                st[0][kt] = __builtin_amdgcn_mfma_f32_16x16x32_bf16(kf, qf[0][kk], st[0][kt], 0, 0, 0);
                st[1][kt] = __builtin_amdgcn_mfma_f32_16x16x32_bf16(kf, qf[1][kk], st[1][kt], 0, 0, 0);
            }
        }
        bf16x8 pb[2][5]; float linv[2];
#pragma unroll
        for (int qt = 0; qt < 2; ++qt) {
            const int tq = tq0 + qt * 16 + fr;
            float mx = sink;
#pragma unroll
            for (int kt = 0; kt < 10; ++kt)
#pragma unroll
                for (int j = 0; j < 4; ++j) {
                    const int jb = jb0 + kt * 16 + fq * 4 + j, rel = 128 + tq - jb;
                    const bool ok = rel >= 0 && rel <= 128 && (qb > 0 || jb >= 128);
                    const float s = ok ? st[qt][kt][j] : -INFINITY;
                    st[qt][kt][j] = s; mx = fmaxf(mx, s);
                }
            mx = fmaxf(mx, __shfl_xor(mx, 16)); mx = fmaxf(mx, __shfl_xor(mx, 32));
            float l = 0.f;
#pragma unroll
            for (int kt = 0; kt < 10; ++kt)
#pragma unroll
                for (int j = 0; j < 4; ++j) { const float p = __expf(st[qt][kt][j] - mx); st[qt][kt][j] = p; l += p; }
            l += __shfl_xor(l, 16); l += __shfl_xor(l, 32);
            l += __expf(sink - mx);
            linv[qt] = 1.0f / l;
#pragma unroll
            for (int sl = 0; sl < 5; ++sl) {
                const f32x4 p0 = st[qt][2 * sl], p1 = st[qt][2 * sl + 1];
                u32x4 w; w.x = pk2(p0[0], p0[1]); w.y = pk2(p0[2], p0[3]); w.z = pk2(p1[0], p1[1]); w.w = pk2(p1[2], p1[3]);
                pb[qt][sl] = __builtin_bit_cast(bf16x8, w);
            }
        }
        f32x4 ot[2][4];
#pragma unroll
        for (int dt = 0; dt < 4; ++dt) { ot[0][dt] = (f32x4){0.f, 0.f, 0.f, 0.f}; ot[1][dt] = (f32x4){0.f, 0.f, 0.f, 0.f}; }
#pragma unroll
        for (int sl = 0; sl < 5; ++sl)
#pragma unroll
            for (int dt = 0; dt < 4; ++dt) {
                const LAS unsigned char* vp = Vt + (dt * 16 + fr) * 528 + (jb0 + sl * 32 + fq * 4) * 2;
                const u32x2 v0 = *(const LAS u32x2*)vp, v1 = *(const LAS u32x2*)(vp + 32);
                const u32x4 vw = (u32x4){v0.x, v0.y, v1.x, v1.y};
                const bf16x8 vf = __builtin_bit_cast(bf16x8, vw);
                ot[0][dt] = __builtin_amdgcn_mfma_f32_16x16x32_bf16(vf, pb[0][sl], ot[0][dt], 0, 0, 0);
                ot[1][dt] = __builtin_amdgcn_mfma_f32_16x16x32_bf16(vf, pb[1][sl], ot[1][dt], 0, 0, 0);
            }
#pragma unroll
        for (int qt = 0; qt < 2; ++qt) {
            bf16_t* op = OA + (size_t)(b * 2048 + qb * 128 + tq0 + qt * 16 + fr) * 1024 + h * 64 + fq * 4;
#pragma unroll
            for (int dt = 0; dt < 4; ++dt) {
                const f32x4 o = ot[qt][dt] * linv[qt];
                u32x2 w; w.x = pk2(o[0], o[1]); w.y = pk2(o[2], o[3]);
                *(u32x2*)(op + dt * 16) = w;
            }
        }
    }
    __syncthreads();
}

__device__ __forceinline__ void attn_sample_task(const Ctx& C, int task, int l, PK p, const bf16_t* P, bf16_t* OA) {
    const int b = task >> 3, h = task & 7, kvh = h >> 2, lane = C.lane;
    const size_t row = (size_t)TP + b;
    const float* ck = p->cache_k + ((size_t)(l * 128 + b) * 128) * 128 + kvh * 64;
    const float* cv = p->cache_v + ((size_t)(l * 128 + b) * 128) * 128 + kvh * 64;
    u32x4 qw[8];
#pragma unroll
    for (int i = 0; i < 8; ++i) qw[i] = *(const u32x4*)(P + row * NIN + PC_Q + h * 64 + i * 8);
    float s0 = 0.f, s1 = 0.f, s2 = 0.f;
    {
        const float* k0 = ck + (size_t)lane * 128; const float* k1 = ck + (size_t)(lane + 64) * 128;
#pragma unroll
        for (int i = 0; i < 8; ++i) {
            const f32x4 a0 = *(const f32x4*)(k0 + i * 8), a1 = *(const f32x4*)(k0 + i * 8 + 4), b0 = *(const f32x4*)(k1 + i * 8), b1 = *(const f32x4*)(k1 + i * 8 + 4);
            const float q0 = bflo(qw[i].x), q1 = bfhi(qw[i].x), q2 = bflo(qw[i].y), q3 = bfhi(qw[i].y), q4 = bflo(qw[i].z), q5 = bfhi(qw[i].z), q6 = bflo(qw[i].w), q7 = bfhi(qw[i].w);
            s0 += q0 * a0[0] + q1 * a0[1] + q2 * a0[2] + q3 * a0[3] + q4 * a1[0] + q5 * a1[1] + q6 * a1[2] + q7 * a1[3];
            s1 += q0 * b0[0] + q1 * b0[1] + q2 * b0[2] + q3 * b0[3] + q4 * b1[0] + q5 * b1[1] + q6 * b1[2] + q7 * b1[3];
            const u32x4 kn = *(const u32x4*)(P + row * NIN + PC_K + kvh * 64 + i * 8);
            s2 += q0 * bflo(kn.x) + q1 * bfhi(kn.x) + q2 * bflo(kn.y) + q3 * bfhi(kn.y) + q4 * bflo(kn.z) + q5 * bfhi(kn.z) + q6 * bflo(kn.w) + q7 * bfhi(kn.w);
        }
    }
    const float sink = p->sinks[l * 8 + h];
    float mx = fmaxf(fmaxf(s0, s1), fmaxf(s2, sink));
#pragma unroll
    for (int o = 1; o < 64; o <<= 1) mx = fmaxf(mx, __shfl_xor(mx, o));
    const float p0 = __expf(s0 - mx), p1 = __expf(s1 - mx), p2 = __expf(s2 - mx);
    const float lsum = wave_sum(p0 + p1) + p2 + __expf(sink - mx);
    float o = p2 * bf1(P[row * NIN + PC_V + kvh * 64 + lane]);
#pragma unroll 8
    for (int j = 0; j < 64; ++j) {
        const float pa = __shfl(p0, j), pbv = __shfl(p1, j);
        o += pa * cv[(size_t)j * 128 + lane] + pbv * cv[(size_t)(j + 64) * 128 + lane];
    }
    OA[row * 1024 + h * 64 + lane] = (bf16_t)f2bf(o / lsum);
    if ((h & 3) == 0) {
        float* ok = p->out + O_KS + ((size_t)(l * 128 + b) * 128) * 128 + kvh * 64;
        float* ov = p->out + O_VS + ((size_t)(l * 128 + b) * 128) * 128 + kvh * 64;
        for (int j = 0; j < 127; ++j) { ok[(size_t)j * 128 + lane] = ck[(size_t)(j + 1) * 128 + lane]; ov[(size_t)j * 128 + lane] = cv[(size_t)(j + 1) * 128 + lane]; }
        ok[(size_t)127 * 128 + lane] = bf1(P[row * NIN + PC_K + kvh * 64 + lane]); ov[(size_t)127 * 128 + lane] = bf1(P[row * NIN + PC_V + kvh * 64 + lane]);
    }
}

__device__ __forceinline__ void dn_sample_task(const Ctx& C, int task, int l, PK p, const bf16_t* P, const float* BG, bf16_t* OD) {
    const int b = task >> 2, h = task & 3, tid = C.tid;
    const size_t row = (size_t)TP + b;
    LAS float* sq = (LAS float*)C.lds;
    LAS float* red = sq + 384;
    LAS float* scal = red + 512;
    const float* sc = p->state_conv + (size_t)(l * 128 + b) * 3 * 1536;
    float s[32];
    {
        const float* S0h = p->state_dn + ((size_t)(l * 128 + b) * 4 + h) * 16384 + (size_t)(tid >> 7) * 32 * 128 + (tid & 127);
#pragma unroll
        for (int dd = 0; dd < 32; ++dd) s[dd] = S0h[(size_t)dd * 128];
    }
    if (tid < 384) {
        const int which = tid >> 7, ch = tid & 127, c = which * 512 + h * 128 + ch;
        const float* cw = p->conv_w + (size_t)l * 4 * 1536 + c;
        const float x0 = sc[c], x1 = sc[1536 + c], x2 = sc[3072 + c], x3 = bf1(P[row * NIN + PC_RAW + c]);
        const float y = x0 * cw[0] + x1 * cw[1536] + x2 * cw[3072] + x3 * cw[4608];
        sq[which * 128 + ch] = siluf_(y);
        float* oc = p->out + O_CVS + (size_t)(l * 128 + b) * 3 * 1536;
        oc[c] = x1; oc[1536 + c] = x2; oc[3072 + c] = x3;
    }
    __syncthreads();
    if (C.wave < 2) {
        const float a = sq[C.wave * 128 + C.lane], bq = sq[C.wave * 128 + 64 + C.lane];
        const float ssum = wave_sum(a * a + bq * bq);
        if (C.lane == 0) scal[C.wave] = rsqrtf(ssum + EPS);
    }
    __syncthreads();
    const float qsc = scal[0] * 0.08838834764831845f, ksc = scal[1];
    const float beta = sigmoidf_(BG[row * 8 + h]);
    const float gdec = __expf(-__expf(p->A_log[l * 4 + h]) * softplusf_(BG[row * 8 + 4 + h] + p->dt_bias[l * 4 + h]));
    const int e = tid & 127, dq = tid >> 7;
    const float* S0 = p->state_dn + ((size_t)(l * 128 + b) * 4 + h) * 16384;
    float* So = p->out + O_DNS + ((size_t)(l * 128 + b) * 4 + h) * 16384;
    float pred = 0.f;
#pragma unroll
    for (int dd = 0; dd < 32; ++dd) { const int d = dq * 32 + dd; s[dd] *= gdec; pred += sq[128 + d] * ksc * s[dd]; }
    red[dq * 128 + e] = pred;
    __syncthreads();
    const float predt = red[e] + red[128 + e] + red[256 + e] + red[384 + e];
    const float delta = beta * (sq[256 + e] - predt);
    float o = 0.f;
#pragma unroll
    for (int dd = 0; dd < 32; ++dd) { const int d = dq * 32 + dd; s[dd] += sq[128 + d] * ksc * delta; So[(size_t)d * 128 + e] = s[dd]; o += sq[d] * qsc * s[dd]; }
    __syncthreads();
    red[dq * 128 + e] = o;
    __syncthreads();
    if (tid < 128) {
        const float ot = red[e] + red[128 + e] + red[256 + e] + red[384 + e];
        const float ssum = wave_sum(ot * ot);
        if (C.lane == 0) scal[2 + C.wave] = ssum;
        sq[e] = ot;
    }
    __syncthreads();
    if (tid < 128) {
        const float rs = rsqrtf((scal[2] + scal[3]) * (1.0f / 128.0f) + EPS);
        const float z = bf1(P[row * NIN + PC_Z + h * 128 + e]);
        OD[row * 1024 + 512 + h * 128 + e] = (bf16_t)f2bf(sq[e] * rs * p->dn_out_norm[l * 128 + e] * siluf_(z));
    }
    __syncthreads();
}

__device__ __forceinline__ void dn_pre_unit(const Ctx& C, int unit, int l, PK p, const bf16_t* P, const float* BG) {
    const int h = unit & 3, n = (unit >> 2) & 31, b = unit >> 7;
    const int tid = C.tid, lane = C.lane, w = C.wave, fr = lane & 15, fq = lane >> 4;
    LAS unsigned char* Ks = C.lds;
    LAS unsigned char* Qs = C.lds + 17408;
    LAS unsigned char* Vt = C.lds + 34816;
    LAS unsigned char* KtW = C.lds + 53248;
    LAS unsigned char* KdT = C.lds + 71680;
    LAS float* A2 = (LAS float*)(C.lds + 90112);
    LAS unsigned char* Ts = C.lds + 106496;
    LAS float* sG = (LAS float*)(C.lds + 115712);
    LAS float* sB = sG + 64;
    unsigned char* ws = p->ws;
    float* UT = (float*)(ws + WS_UT) + (size_t)unit * 8192;
    bf16_t* WN = (bf16_t*)(ws + WS_WN) + (size_t)unit * 8192;
    bf16_t* QD = (bf16_t*)(ws + WS_QD) + (size_t)unit * 8192;
    bf16_t* KDT = (bf16_t*)(ws + WS_KDT) + (size_t)unit * 8192;
    bf16_t* QK = (bf16_t*)(ws + WS_QK) + (size_t)unit * 4096;
    const int row0 = b * 2048 + n * 64;
    u32x4 pre[2][4][2];
    {
        const int t = tid >> 3, ch0 = (tid & 7) * 16;
#pragma unroll
        for (int which = 0; which < 2; ++which)
#pragma unroll
            for (int i = 0; i < 4; ++i) {
                const int tt = n * 64 + t - 3 + i;
                pre[which][i][0] = (u32x4){0u, 0u, 0u, 0u}; pre[which][i][1] = (u32x4){0u, 0u, 0u, 0u};
                if (tt >= 0) { const bf16_t* rp = P + (size_t)(b * 2048 + tt) * NIN + PC_RAW + which * 512 + h * 128 + ch0; pre[which][i][0] = *(const u32x4*)rp; pre[which][i][1] = *(const u32x4*)(rp + 8); }
            }
    }
    if (w == 0) {
        const float bb = BG[(size_t)(row0 + lane) * 8 + h], aa = BG[(size_t)(row0 + lane) * 8 + 4 + h];
        const float beta = sigmoidf_(bb);
        float gsum = -__expf(p->A_log[l * 4 + h]) * softplusf_(aa + p->dt_bias[l * 4 + h]);
#pragma unroll
        for (int o = 1; o < 64; o <<= 1) { const float t = __shfl_up(gsum, o); if (lane >= o) gsum += t; }
        sG[lane] = gsum; sB[lane] = beta;
        if (lane == 63) ((float*)(ws + WS_GL))[unit] = __expf(gsum);
    }
    __syncthreads();
    for (int r2_ = 0; r2_ < 1 + ((SUBREP >> 8) & 1); ++r2_)
    {
        const int t = tid >> 3, ch0 = (tid & 7) * 16;
        const float Gt = sG[t], bt = sB[t], eG = __expf(Gt), eGl = __expf(sG[63] - Gt);
#pragma unroll
        for (int which = 0; which < 3; ++which) {
            const int c = which * 512 + h * 128 + ch0;
            float y[16];
#pragma unroll
            for (int q = 0; q < 16; ++q) y[q] = 0.f;
#pragma unroll
            for (int i = 0; i < 4; ++i) {
                const int tt = n * 64 + t - 3 + i;
                if (tt >= 0) {
                    u32x4 x0, x1;
                    if (which < 2) { x0 = pre[which < 2 ? which : 0][i][0]; x1 = pre[which < 2 ? which : 0][i][1]; }
                    else { const bf16_t* rp = P + (size_t)(b * 2048 + tt) * NIN + PC_RAW + c; x0 = *(const u32x4*)rp; x1 = *(const u32x4*)(rp + 8); }
                    const float* cw = p->conv_w + ((size_t)l * 4 + i) * 1536 + c;
                    const f32x4 w0 = *(const f32x4*)cw, w1 = *(const f32x4*)(cw + 4), w2 = *(const f32x4*)(cw + 8), w3 = *(const f32x4*)(cw + 12);
                    y[0] += bflo(x0.x) * w0[0]; y[1] += bfhi(x0.x) * w0[1]; y[2] += bflo(x0.y) * w0[2]; y[3] += bfhi(x0.y) * w0[3];
                    y[4] += bflo(x0.z) * w1[0]; y[5] += bfhi(x0.z) * w1[1]; y[6] += bflo(x0.w) * w1[2]; y[7] += bfhi(x0.w) * w1[3];
                    y[8] += bflo(x1.x) * w2[0]; y[9] += bfhi(x1.x) * w2[1]; y[10] += bflo(x1.y) * w2[2]; y[11] += bfhi(x1.y) * w2[3];
                    y[12] += bflo(x1.z) * w3[0]; y[13] += bfhi(x1.z) * w3[1]; y[14] += bflo(x1.w) * w3[2]; y[15] += bfhi(x1.w) * w3[3];
                }
            }
            float ss = 0.f;
#pragma unroll
            for (int q = 0; q < 16; ++q) { y[q] = siluf_(y[q]); ss += y[q] * y[q]; }
            if (which < 2) { ss += __shfl_xor(ss, 1); ss += __shfl_xor(ss, 2); ss += __shfl_xor(ss, 4); }
            if (which == 0) {
                const float sc = rsqrtf(ss + EPS) * 0.08838834764831845f;
                u32x4 a, d2, qa, qb2;
                a.x = pk2(y[0] * sc, y[1] * sc); a.y = pk2(y[2] * sc, y[3] * sc); a.z = pk2(y[4] * sc, y[5] * sc); a.w = pk2(y[6] * sc, y[7] * sc);
                d2.x = pk2(y[8] * sc, y[9] * sc); d2.y = pk2(y[10] * sc, y[11] * sc); d2.z = pk2(y[12] * sc, y[13] * sc); d2.w = pk2(y[14] * sc, y[15] * sc);
                *(LAS u32x4*)(Qs + t * 272 + ch0 * 2) = a; *(LAS u32x4*)(Qs + t * 272 + ch0 * 2 + 16) = d2;
                const float s2 = sc * eG;
                qa.x = pk2(y[0] * s2, y[1] * s2); qa.y = pk2(y[2] * s2, y[3] * s2); qa.z = pk2(y[4] * s2, y[5] * s2); qa.w = pk2(y[6] * s2, y[7] * s2);
                qb2.x = pk2(y[8] * s2, y[9] * s2); qb2.y = pk2(y[10] * s2, y[11] * s2); qb2.z = pk2(y[12] * s2, y[13] * s2); qb2.w = pk2(y[14] * s2, y[15] * s2);
                *(u32x4*)(QD + t * 128 + ch0) = qa; *(u32x4*)(QD + t * 128 + ch0 + 8) = qb2;
            } else if (which == 1) {
                const float sc = rsqrtf(ss + EPS);
                u32x4 a, d2;
                a.x = pk2(y[0] * sc, y[1] * sc); a.y = pk2(y[2] * sc, y[3] * sc); a.z = pk2(y[4] * sc, y[5] * sc); a.w = pk2(y[6] * sc, y[7] * sc);
                d2.x = pk2(y[8] * sc, y[9] * sc); d2.y = pk2(y[10] * sc, y[11] * sc); d2.z = pk2(y[12] * sc, y[13] * sc); d2.w = pk2(y[14] * sc, y[15] * sc);
                *(LAS u32x4*)(Ks + t * 272 + ch0 * 2) = a; *(LAS u32x4*)(Ks + t * 272 + ch0 * 2 + 16) = d2;
                const float s1 = sc * bt * eG, s3 = sc * eGl;
#pragma unroll
                for (int q = 0; q < 16; ++q) {
                    *(LAS bf16_t*)(KtW + (ch0 + q) * 144 + t * 2) = (bf16_t)f2bf(y[q] * s1);
                    *(LAS bf16_t*)(KdT + (ch0 + q) * 144 + t * 2) = (bf16_t)f2bf(y[q] * s3);
                }
            } else {
#pragma unroll
                for (int q = 0; q < 16; ++q) *(LAS bf16_t*)(Vt + (ch0 + q) * 144 + t * 2) = (bf16_t)f2bf(y[q] * bt);
            }
        }
    }
    __syncthreads();
    {
        const int itile = w & 3; const bool isq = w >= 4;
        LAS unsigned char* Arows = isq ? Qs : Ks;
        bf16x8 af[4];
#pragma unroll
        for (int k4 = 0; k4 < 4; ++k4) af[k4] = *(const LAS bf16x8*)(Arows + (itile * 16 + fr) * 272 + (k4 * 32 + fq * 8) * 2);
#pragma unroll
        for (int jt = 0; jt < 4; ++jt) {
            f32x4 acc = (f32x4){0.f, 0.f, 0.f, 0.f};
#pragma unroll
            for (int k4 = 0; k4 < 4; ++k4) {
                const bf16x8 bfv = *(const LAS bf16x8*)(Ks + (jt * 16 + fr) * 272 + (k4 * 32 + fq * 8) * 2);
                acc = __builtin_amdgcn_mfma_f32_16x16x32_bf16(af[k4], bfv, acc, 0, 0, 0);
            }
            const int j = jt * 16 + fr; const float Gj = sG[j];
#pragma unroll
            for (int jj = 0; jj < 4; ++jj) {
                const int i = itile * 16 + fq * 4 + jj;
                const float dec = __expf(sG[i] - Gj);
                if (!isq) A2[i * 64 + (j & 7) * 8 + (j >> 3)] = (j < i) ? sB[i] * acc[jj] * dec : 0.f;
                else *(LAS bf16_t*)(Qs + i * 272 + j * 2) = (bf16_t)f2bf((j <= i) ? acc[jj] * dec : 0.f);
            }
        }
    }
    __syncthreads();
    { const int r = tid >> 3, ch = tid & 7; *(u32x4*)(QK + r * 64 + ch * 8) = *(const LAS u32x4*)(Qs + r * 272 + ch * 16); }
    for (int r2_ = 0; r2_ < 1 + ((SUBREP >> 9) & 1); ++r2_)
    {
        const int c = w * 8 + (lane >> 3), jg = lane & 7;
        float tt[8];
#pragma unroll
        for (int q = 0; q < 8; ++q) tt[q] = 0.f;
        f32x4 na0 = *(const LAS f32x4*)(A2 + jg * 8), na1 = *(const LAS f32x4*)(A2 + jg * 8 + 4);
#pragma unroll 1
        for (int i = 0; i < 64; ++i) {
            const f32x4 a0 = na0, a1 = na1;
            { const int i2 = (i + 1) & 63; na0 = *(const LAS f32x4*)(A2 + i2 * 64 + jg * 8); na1 = *(const LAS f32x4*)(A2 + i2 * 64 + jg * 8 + 4); }
            float part = (a0[0] * tt[0] + a0[1] * tt[1]) + (a0[2] * tt[2] + a0[3] * tt[3]) + ((a1[0] * tt[4] + a1[1] * tt[5]) + (a1[2] * tt[6] + a1[3] * tt[7]));
            part += __builtin_bit_cast(float, __builtin_amdgcn_update_dpp(0, __builtin_bit_cast(int, part), 0xB1, 0xF, 0xF, true));
            part += __builtin_bit_cast(float, __builtin_amdgcn_update_dpp(0, __builtin_bit_cast(int, part), 0x4E, 0xF, 0xF, true));
            part += __builtin_bit_cast(float, __builtin_amdgcn_update_dpp(0, __builtin_bit_cast(int, part), 0x141, 0xF, 0xF, true));
            const float tv = ((i == c) ? 1.0f : 0.0f) - part;
            const bool mine = jg == (i & 7); const int qi = i >> 3;
#pragma unroll
            for (int q = 0; q < 8; ++q) tt[q] = (mine && q == qi) ? tv : tt[q];
        }
#pragma unroll
        for (int q = 0; q < 8; ++q) *(LAS bf16_t*)(Ts + (jg + 8 * q) * 144 + c * 2) = (bf16_t)f2bf(tt[q]);
    }
    __syncthreads();
    {
        bf16x8 va[2], ka[2];
#pragma unroll
        for (int k2 = 0; k2 < 2; ++k2) {
            va[k2] = *(const LAS bf16x8*)(Vt + (w * 16 + fr) * 144 + (k2 * 32 + fq * 8) * 2);
            ka[k2] = *(const LAS bf16x8*)(KtW + (w * 16 + fr) * 144 + (k2 * 32 + fq * 8) * 2);
        }
#pragma unroll
        for (int jt = 0; jt < 4; ++jt) {
            f32x4 au = (f32x4){0.f, 0.f, 0.f, 0.f}, aw = (f32x4){0.f, 0.f, 0.f, 0.f};
#pragma unroll
            for (int k2 = 0; k2 < 2; ++k2) {
                const bf16x8 tf = *(const LAS bf16x8*)(Ts + (jt * 16 + fr) * 144 + (k2 * 32 + fq * 8) * 2);
                au = __builtin_amdgcn_mfma_f32_16x16x32_bf16(va[k2], tf, au, 0, 0, 0);
                aw = __builtin_amdgcn_mfma_f32_16x16x32_bf16(tf, ka[k2], aw, 0, 0, 0);
            }
            *(f32x4*)(UT + ((size_t)(w * 4 + jt) * 64 + lane) * 4) = au;
#pragma unroll
            for (int jj = 0; jj < 4; ++jj) *(LAS bf16_t*)(Ks + (jt * 16 + fq * 4 + jj) * 272 + (w * 16 + fr) * 2) = (bf16_t)f2bf(-aw[jj]);
        }
#pragma unroll
        for (int pp = 0; pp < 2; ++pp) {
            const int id = tid + pp * 512, r = id >> 3, ch = id & 7;
            *(u32x4*)(KDT + r * 64 + ch * 8) = *(const LAS u32x4*)(KdT + r * 144 + ch * 16);
        }
    }
    __syncthreads();
#pragma unroll
    for (int pp = 0; pp < 2; ++pp) { const int id = tid + pp * 512, r = id >> 4, ch = id & 15; *(u32x4*)(WN + r * 128 + ch * 8) = *(const LAS u32x4*)(Ks + r * 272 + ch * 16); }
    __syncthreads();
}

struct ScanFrags { bf16x8 wn[4]; bf16x8 qd[4]; bf16x8 qk[2]; bf16x8 kd[1][2]; f32x4 ut; float gl; };
__device__ __forceinline__ void scan_load(ScanFrags& f, PK p, int unit, int s, int w, int lane) {
    const int fr = lane & 15, fq = lane >> 4, et = w >> 2, xt = w & 3;
    const unsigned char* ws = p->ws;
    const bf16_t* WN = (const bf16_t*)(ws + WS_WN) + (size_t)unit * 8192;
    const bf16_t* QD = (const bf16_t*)(ws + WS_QD) + (size_t)unit * 8192;
    const bf16_t* KDT = (const bf16_t*)(ws + WS_KDT) + (size_t)unit * 8192;
    const bf16_t* QK = (const bf16_t*)(ws + WS_QK) + (size_t)unit * 4096;
    const float* UT = (const float*)(ws + WS_UT) + (size_t)unit * 8192;
#pragma unroll
    for (int k4 = 0; k4 < 4; ++k4) { f.wn[k4] = *(const bf16x8*)(WN + (xt * 16 + fr) * 128 + k4 * 32 + fq * 8); f.qd[k4] = *(const bf16x8*)(QD + (xt * 16 + fr) * 128 + k4 * 32 + fq * 8); }
#pragma unroll
    for (int k2 = 0; k2 < 2; ++k2) { f.qk[k2] = *(const bf16x8*)(QK + (xt * 16 + fr) * 64 + k2 * 32 + fq * 8); f.kd[0][k2] = *(const bf16x8*)(KDT + (w * 16 + fr) * 64 + k2 * 32 + fq * 8); }
    f.ut = *(const f32x4*)(UT + ((size_t)((s * 2 + et) * 4 + xt) * 64 + lane) * 4);
    { int z_ = 0; asm volatile("" : "+v"(z_)); f.gl = ((const float*)(ws + WS_GL))[unit + z_]; }
}
#define LBAR() do { asm volatile("s_waitcnt lgkmcnt(0)" ::: "memory"); __builtin_amdgcn_s_barrier(); asm volatile("" ::: "memory"); } while (0)
struct ScanState { f32x4 sacc[2]; };
__device__ __forceinline__ void scan_step(const ScanFrags& cur, ScanState& S, LAS unsigned char* St, LAS unsigned char* uT, float* ODF, int b, int h, int s, int n, int w, int lane) {
    const int fr = lane & 15, fq = lane >> 4, et = w >> 2, xt = w & 3;
    bf16x8 sa[4];
#pragma unroll
    for (int k4 = 0; k4 < 4; ++k4) sa[k4] = *(const LAS bf16x8*)(St + (et * 16 + fr) * 272 + (k4 * 32 + fq * 8) * 2);
    f32x4 u = cur.ut;
#pragma unroll
    for (int k4 = 0; k4 < 4; ++k4) u = __builtin_amdgcn_mfma_f32_16x16x32_bf16(sa[k4], cur.wn[k4], u, 0, 0, 0);
#pragma unroll
    for (int jj = 0; jj < 4; ++jj) *(LAS bf16_t*)(uT + (et * 16 + fq * 4 + jj) * 144 + (xt * 16 + fr) * 2) = (bf16_t)f2bf(u[jj]);
    f32x4 o = (f32x4){0.f, 0.f, 0.f, 0.f};
#pragma unroll
    for (int k4 = 0; k4 < 4; ++k4) o = __builtin_amdgcn_mfma_f32_16x16x32_bf16(sa[k4], cur.qd[k4], o, 0, 0, 0);
    LBAR();
    bf16x8 ua[2];
#pragma unroll
    for (int k2 = 0; k2 < 2; ++k2) ua[k2] = *(const LAS bf16x8*)(uT + (et * 16 + fr) * 144 + (k2 * 32 + fq * 8) * 2);
#pragma unroll
    for (int k2 = 0; k2 < 2; ++k2) o = __builtin_amdgcn_mfma_f32_16x16x32_bf16(ua[k2], cur.qk[k2], o, 0, 0, 0);
    *(f32x4*)(ODF + (size_t)(b * 2048 + n * 64 + xt * 16 + fr) * 512 + h * 128 + s * 32 + et * 16 + fq * 4) = o;
#pragma unroll
    for (int e2 = 0; e2 < 2; ++e2) {
        bf16x8 ue[2];
#pragma unroll
        for (int k2 = 0; k2 < 2; ++k2) ue[k2] = *(const LAS bf16x8*)(uT + (e2 * 16 + fr) * 144 + (k2 * 32 + fq * 8) * 2);
        f32x4 a = S.sacc[e2] * cur.gl;
#pragma unroll
        for (int k2 = 0; k2 < 2; ++k2) a = __builtin_amdgcn_mfma_f32_16x16x32_bf16(ue[k2], cur.kd[0][k2], a, 0, 0, 0);
        S.sacc[e2] = a;
    }
    LBAR();
#pragma unroll
    for (int e2 = 0; e2 < 2; ++e2)
#pragma unroll
        for (int jj = 0; jj < 4; ++jj) *(LAS bf16_t*)(St + (e2 * 16 + fq * 4 + jj) * 272 + (w * 16 + fr) * 2) = (bf16_t)f2bf(S.sacc[e2][jj]);
    LBAR();
}
__device__ __forceinline__ void dn_scan(const Ctx& C, int l, PK p) {
    if (C.bid >= 128) return;
    const int q_ = C.bid >> 3, s = q_ & 3, chain = (C.bid & 7) + 8 * (q_ >> 2), b = chain >> 2, h = chain & 3;
    const int w = C.wave, lane = C.lane, fr = lane & 15, fq = lane >> 4;
    LAS unsigned char* St = C.lds;
    LAS unsigned char* uT = C.lds + 8704;
    float* ODF = (float*)(p->ws + WS_ODF);
    ScanState S;
    S.sacc[0] = (f32x4){0.f, 0.f, 0.f, 0.f}; S.sacc[1] = (f32x4){0.f, 0.f, 0.f, 0.f};
    for (int i = C.tid; i < 8704 / 4; i += 512) ((LAS unsigned*)St)[i] = 0u;
    ScanFrags fa, fb, fc;
    const int u0 = (b * 32) * 4 + h;
    scan_load(fa, p, u0, s, w, lane);
    scan_load(fb, p, u0 + 4, s, w, lane);
    __syncthreads();
#pragma unroll 1
    for (int n = 0; n < 33; n += 3) {
        if (n + 2 < 32) scan_load(fc, p, u0 + (n + 2) * 4, s, w, lane);
        scan_step(fa, S, St, uT, ODF, b, h, s, n, w, lane);
        if (n + 3 < 32) scan_load(fa, p, u0 + (n + 3) * 4, s, w, lane);
        scan_step(fb, S, St, uT, ODF, b, h, s, n + 1, w, lane);
        if (n + 2 >= 32) break;
        if (n + 4 < 32) scan_load(fb, p, u0 + (n + 4) * 4, s, w, lane);
        scan_step(fc, S, St, uT, ODF, b, h, s, n + 2, w, lane);
    }
    float* So = p->out + O_DNP + ((size_t)(l * 8 + b) * 4 + h) * 16384;
#pragma unroll
    for (int e2 = 0; e2 < 2; ++e2)
#pragma unroll
        for (int jj = 0; jj < 4; ++jj) So[(size_t)(w * 16 + fr) * 128 + s * 32 + e2 * 16 + fq * 4 + jj] = S.sacc[e2][jj];
}

__device__ __forceinline__ void sample_merge(const Ctx& C, const bf16_t* wa, const bf16_t* wd, const bf16_t* OA, const bf16_t* OD, const bf16_t* P, bf16_t* MRG) {
    const int ct = C.bid, rt = C.wave, fr = C.lane & 15, fq = C.lane >> 4;
    const int lc = ct * 16 + fr, lg = lc & 31;
    const int phys = (lc & ~31) + ((lg >> 2) & 1) * 16 + (lg >> 3) * 4 + (lg & 3);
    const bf16_t* war = wa + (size_t)phys * 1024 + fq * 8; const bf16_t* wdr = wa + (size_t)phys * 1024 + 512 + fq * 8; (void)wd;
    const size_t trow = (size_t)TP + rt * 16 + fr;
    const bf16_t* xar = OA + trow * 1024 + fq * 8; const bf16_t* xdr = OA + trow * 1024 + 512 + fq * 8; (void)OD;
    f32x4 aa = (f32x4){0.f, 0.f, 0.f, 0.f}, ad = (f32x4){0.f, 0.f, 0.f, 0.f};
#pragma unroll 4
    for (int k = 0; k < 16; ++k) {
        const bf16x8 wfa = *(const bf16x8*)(war + k * 32), wfd = *(const bf16x8*)(wdr + k * 32);
        const bf16x8 xa = *(const bf16x8*)(xar + k * 32), xd = *(const bf16x8*)(xdr + k * 32);
        aa = __builtin_amdgcn_mfma_f32_16x16x32_bf16(wfa, xa, aa, 0, 0, 0);
        ad = __builtin_amdgcn_mfma_f32_16x16x32_bf16(wfd, xd, ad, 0, 0, 0);
    }
    const int col0 = ct * 16 + fq * 4;
    const u32x2 ga = *(const u32x2*)(P + trow * NIN + PC_GA + col0), gd = *(const u32x2*)(P + trow * NIN + PC_GD + col0);
    u32x2 w;
    w.x = pk2(sigmoidf_(bflo(ga.x)) * aa[0] + sigmoidf_(bflo(gd.x)) * ad[0], sigmoidf_(bfhi(ga.x)) * aa[1] + sigmoidf_(bfhi(gd.x)) * ad[1]);
    w.y = pk2(sigmoidf_(bflo(ga.y)) * aa[2] + sigmoidf_(bflo(gd.y)) * ad[2], sigmoidf_(bfhi(ga.y)) * aa[3] + sigmoidf_(bfhi(gd.y)) * ad[3]);
    *(u32x2*)(MRG + trow * DM + col0) = w;
}

#define XB_TMO      128
#define XB_XCNT(j)  (256  + 64 * (j))
#define XB_XSUB(j)  (1280 + 64 * (j))
#define XB_XGEN(j)  (2304 + 64 * (j))
#define XB_TOP      3328
#define XB_TOPGEN   3392
#define XCD_BAR_WORDS 3456
#define XB_SPIN_CAP (1u << 20)
__device__ __forceinline__ unsigned xb_ld(unsigned* p)              { return __hip_atomic_load(p, __ATOMIC_RELAXED, __HIP_MEMORY_SCOPE_AGENT); }
__device__ __forceinline__ unsigned xb_add(unsigned* p, unsigned v) { return __hip_atomic_fetch_add(p, v, __ATOMIC_RELAXED, __HIP_MEMORY_SCOPE_AGENT); }
__device__ __forceinline__ unsigned xb_xcc_id() { return (unsigned)__builtin_amdgcn_s_getreg((3 << 11) | 20) & 0xFu; }
#define XB_SPIN(cond, bar) do { unsigned _sp = 0; while (cond) { __builtin_amdgcn_s_sleep(1); \
    if ((++_sp & 255u) == 0u) { if (xb_ld(&(bar)[XB_TMO])) break; if (_sp > XB_SPIN_CAP) { atomicAdd(&(bar)[XB_TMO], 1u); break; } } } } while (0)
struct XcdBarrier { unsigned* bar; unsigned x; volatile LAS unsigned* st; };
__device__ __forceinline__ XcdBarrier xcd_barrier_post(unsigned* bar, volatile LAS unsigned* st) {
    XcdBarrier b; b.bar = bar; b.x = xb_xcc_id(); b.st = st;
    if (threadIdx.x == 0) (void)xb_add(&bar[XB_XCNT(b.x)], 1u);
    return b;
}
__device__ __forceinline__ void xcd_barrier_complete(unsigned* bar, unsigned x, unsigned& nloc, unsigned& nx) {
    const unsigned G = gridDim.x * gridDim.y * gridDim.z;
    unsigned sum, cnt, mine, sp = 0u;
    for (;;) {
        sum = 0u; cnt = 0u; mine = 0u;
#pragma unroll
        for (unsigned j = 0; j < 16; ++j) { const unsigned c = xb_ld(&bar[XB_XCNT(j)]); sum += c; cnt += (c > 0u) ? 1u : 0u; mine = (j == x) ? c : mine; }
        if (sum == G) break;
        __builtin_amdgcn_s_sleep(1);
        if ((++sp & 255u) == 0u) { if (xb_ld(&bar[XB_TMO])) break; if (sp > XB_SPIN_CAP) { atomicAdd(&bar[XB_TMO], 1u); break; } }
    }
    nloc = mine > 0u ? mine : 1u; nx = cnt > 0u ? cnt : 1u;
}
__device__ __forceinline__ void xcd_barrier(const XcdBarrier& b) {
    asm volatile("s_waitcnt vmcnt(0)" ::: "memory");
    __syncthreads();
    if (threadIdx.x == 0) {
        unsigned* bar = b.bar;
        __builtin_amdgcn_s_waitcnt(0);
        unsigned nloc = b.st[0], nx = b.st[1];
        if (nloc == 0u) { xcd_barrier_complete(bar, b.x, nloc, nx); b.st[0] = nloc; b.st[1] = nx; }
        const unsigned old = xb_add(&bar[XB_XSUB(b.x)], 1u);
        const unsigned gen = old / nloc;
        if (old + 1u == (gen + 1u) * nloc) {
            __builtin_amdgcn_fence(__ATOMIC_RELEASE, "agent");
            asm volatile("s_waitcnt vmcnt(0)" ::: "memory");
            const unsigned og = xb_add(&bar[XB_TOP], 1u);
            const unsigned tg = og / nx;
            if (og + 1u == (tg + 1u) * nx) xb_add(&bar[XB_TOPGEN], 1u);
            else XB_SPIN(xb_ld(&bar[XB_TOPGEN]) == tg, bar);
            __builtin_amdgcn_fence(__ATOMIC_ACQUIRE, "agent");
            xb_add(&bar[XB_XGEN(b.x)], 1u);
            asm volatile("s_waitcnt vmcnt(0)" ::: "memory");
        } else {
            XB_SPIN(xb_ld(&bar[XB_XGEN(b.x)]) == gen, bar);
            __builtin_amdgcn_fence(__ATOMIC_ACQUIRE, "agent");
            asm volatile("s_waitcnt vmcnt(0)" ::: "memory");
        }
    }
    __syncthreads();
}

#ifndef DISMASK
#define DISMASK 0
#endif
#define EN(x) (((DISMASK >> (x)) & 1) == 0)
#ifndef REPMASK
#define REPMASK 0
#endif
constexpr int NPH = 2 + 13 * DEPTH;
__global__ void __launch_bounds__(512, 2) fwd_megakernel(Params p_unused, int ph_lo, int ph_hi) {
    extern __shared__ __attribute__((aligned(16))) unsigned char lds_raw[];
    cg::grid_group grid = cg::this_grid();
    volatile LAS unsigned* MISC = (volatile LAS unsigned*)((LAS unsigned char*)lds_raw + LDS_BYTES - 64);
    if (threadIdx.x < 16) MISC[threadIdx.x] = 0u;
    __syncthreads();
    const XcdBarrier xbar = xcd_barrier_post((unsigned*)(((PK)__builtin_amdgcn_kernarg_segment_ptr())->ws + WS_BAR), MISC);
#pragma unroll 1
    for (int ph = ph_lo, rep = 0; ph < ph_hi;) {
        const __attribute__((address_space(4))) unsigned char* kp_ = (const __attribute__((address_space(4))) unsigned char*)__builtin_amdgcn_kernarg_segment_ptr();
        asm volatile("" : "+s"(kp_));
        PK p = (PK)kp_;
        unsigned char* ws = p->ws;
        int tid_ = threadIdx.x;
        asm volatile("" : "+v"(tid_));
        Ctx C; C.lds = (LAS unsigned char*)lds_raw; C.tid = tid_; C.lane = C.tid & 63; C.wave = __builtin_amdgcn_readfirstlane(C.tid >> 6); { int g_ = gridDim.x, b_ = blockIdx.x; asm volatile("" : "+s"(g_), "+s"(b_)); C.G = g_; C.bid = b_; }
        bf16_t* WB = (bf16_t*)(ws + WS_W);
        float* H = (float*)(ws + WS_H);
        bf16_t* XN = (bf16_t*)(ws + WS_XN);
        bf16_t* ACT = (bf16_t*)(ws + WS_ACT);
        float* TMP = (float*)(ws + WS_ACT);
        bf16_t* P = (bf16_t*)(ws + WS_P);
        bf16_t* OA = (bf16_t*)(ws + WS_OA);
        bf16_t* OD = (bf16_t*)(ws + WS_OA);
        float* BG = (float*)(ws + WS_BG);
        float2* ROPE = (float2*)(ws + WS_ROPE);
        float* YP = p->out + O_YP; float* YS = p->out + O_YS;
        if (ph == 0 && EN(13)) {
#pragma unroll 1
            for (int l = 0; l < DEPTH; ++l) {
                bf16_t* wl = WB + (size_t)l * WL_END;
                convert_weight(C, p->ffn1_gu + (size_t)l * DM * 5632, 5632, DM, 5632, 1, wl + WL_GU1);
                convert_weight(C, p->ffn1_dn + (size_t)l * FF * DM, DM, FF, DM, 0, wl + WL_DN1);
                convert_weight(C, p->w_in + (size_t)l * DM * NINSRC, NINSRC, DM, NIN, 2, wl + WL_WIN);
                convert_weight(C, p->w_attn_o + (size_t)l * 512 * DM, DM, 512, DM, 0, wl + WL_AO, 1024, 0);
                convert_weight(C, p->w_dn_o + (size_t)l * 512 * DM, DM, 512, DM, 0, wl + WL_AO, 1024, 512);
                convert_weight(C, p->w_out + (size_t)l * DM * DM, DM, DM, DM, 0, wl + WL_WO);
                convert_weight(C, p->ffn2_gu + (size_t)l * DM * 5632, 5632, DM, 5632, 1, wl + WL_GU2);
                convert_weight(C, p->ffn2_dn + (size_t)l * FF * DM, DM, FF, DM, 0, wl + WL_DN2);
            }
            for (int i = C.bid * 512 + C.tid; i < 2049 * 32; i += C.G * 512) {
                const int pi = i >> 5, fi = i & 31;
                const float inv = 1.0f / exp2f((float)fi * (13.287712379549449f / 32.0f));
                const float posf = pi < 2048 ? (float)pi : 8192.0f;
                const float angf = posf * inv;
                const double ang = (double)angf;
                const double r = ang - 6.283185307179586 * rint(ang * 0.15915494309189535);
                const float rf = (float)r;
                ROPE[i] = make_float2(__cosf(rf), __sinf(rf));
            }
        } else if (ph == NPH - 1) {
            const float* PART = (const float*)(ws + WS_PART); const float* HS = H + (size_t)TP * DM;
            for (int r = C.bid * 8 + C.wave; r < TS; r += C.G * 8) {
#pragma unroll
                for (int c = 0; c < 4; ++c) {
                    f32x4 a = (f32x4){0.f, 0.f, 0.f, 0.f};
                    for (int i = 0; i < 11; ++i) a += *(const f32x4*)(PART + ((size_t)i * TS + r) * DM + c * 256 + C.lane * 4);
                    *(f32x4*)(YS + (size_t)r * DM + c * 256 + C.lane * 4) = *(const f32x4*)(HS + (size_t)r * DM + c * 256 + C.lane * 4) + 0.5f * a;
                }
            }
        } else {
            const int l = (ph - 1) / 13, k = (ph - 1) % 13;
            const bf16_t* wl = WB + (size_t)l * WL_END;
            const float* XinP = l == 0 ? p->x_prompt : YP; const float* XinS = l == 0 ? p->x_sample : YS;
            float* HS = H + (size_t)TP * DM;
            float* PART = (float*)(ws + WS_PART);
            if (k == 0 && EN(0)) {
                norm_phase<false>(C, XinP, l == 0 ? XinS : HS, p->ffn1_norm + l * DM, XN, nullptr, nullptr, PART, l == 0 ? 0 : 11, 0.5f, YS);
            } else if ((k == 1 || k == 11) && EN(1)) {
                pg8::Gemm g{XN, wl + (k == 1 ? WL_GU1 : WL_GU2), MP, 5632, DM}; pg8::StaticOrder S; S.init(5632, DM, C.G, C.bid, 128, 22, 16); EpiSwiglu E{ACT}; pg8::gemm_phase(C.lds, g, S, E, C.tid);
            } else if ((k == 2 || k == 12 || k == 9) && EN(2)) {
                pg8::Gemm g{k == 9 ? XN : ACT, wl + (k == 2 ? WL_DN1 : (k == 12 ? WL_DN2 : WL_WO)), MP, DM, k == 9 ? DM : FF}; pg8::StaticOrder S; S.init(DM, k == 9 ? DM : FF, C.G, C.bid, 0, k == 9 ? 16 : 44, 4);
                EpiResid E{k == 2 ? XinP : H, k == 12 ? YP : H, k == 9 ? 1.0f : 0.5f, PART};
                pg8::gemm_phase(C.lds, g, S, E, C.tid);
            } else if (k == 3 && EN(3)) {
                norm_phase<true>(C, H, XinS, p->mix_norm + l * DM, XN, p->w_in + (size_t)l * DM * NINSRC, BG, PART, 11, 0.5f, HS);
            } else if (k == 4 && EN(4)) {
                pg8::Gemm g{XN, wl + WL_WIN, MP, NIN, DM}; pg8::StaticOrder S; S.init(NIN, DM, C.G, C.bid, 192, 19, 16);
                EpiWin E{P, p->q_norm + l * 64, p->k_norm + l * 64, ROPE};
                pg8::gemm_phase(C.lds, g, S, E, C.tid);
            } else if (k == 5 && EN(5)) {
                for (int r_ = 0; r_ < 1 + ((SUBREP >> 1) & 1); ++r_)
                for (int u = C.bid; u < 1024; u += C.G) dn_pre_unit(C, u, l, p, P, BG);
                __syncthreads();
                for (int r_ = 0; r_ < 1 + ((SUBREP >> 3) & 1); ++r_)
                for (int t = C.bid; t < 512; t += C.G) dn_sample_task(C, t, l, p, P, BG, OD);
                for (int i = C.bid * 512 + C.tid; i < 262144; i += C.G * 512) {
                    const int which = i >> 17, r = i & 131071, d = r & 63, kvh = (r >> 6) & 1, j = (r >> 7) & 127, b = r >> 14;
                    const size_t row = (size_t)b * 2048 + 1920 + j;
                    p->out[(which ? O_VP : O_KP) + (size_t)l * 131072 + r] = bf1(P[row * NIN + (which ? PC_V : PC_K) + kvh * 64 + d]);
                }
                for (int i = C.bid * 512 + C.tid; i < 36864; i += C.G * 512) {
                    const int c = i % 1536, j = (i / 1536) % 3, b = i / 4608;
                    const size_t row = (size_t)b * 2048 + 2045 + j;
                    p->out[O_CVP + (size_t)l * 36864 + i] = bf1(P[row * NIN + PC_RAW + c]);
                }
            } else if (k == 6 && EN(6)) {
                if (C.bid < 128 || C.G != 256) dn_scan(C, l, p);
                if (C.bid >= 128 || C.G != 256) {
                const int bid2 = C.G == 256 ? C.bid - 128 : C.bid, G2 = C.G == 256 ? 128 : C.G;
                for (int r_ = 0; r_ < 1 + ((SUBREP >> 0) & 1); ++r_)
                for (int u = bid2; u < 256; u += G2) attn_prompt_unit(C, u, P, p->sinks + l * 8, OA);
                for (int r_ = 0; r_ < 1 + ((SUBREP >> 2) & 1); ++r_)
                for (int t = bid2 * 8 + C.wave; t < 1024; t += G2 * 8) attn_sample_task(C, t, l, p, P, OA);
                }
            } else if (k == 7 && EN(7)) {
                if (C.bid < 64) sample_merge(C, wl + WL_AO, wl + WL_DO, OA, OD, P, XN);
                finalize_od(C, (const float*)(ws + WS_ODF), P, p->dn_out_norm + l * 128, OD);
            } else if (k == 8 && EN(8)) {
                pg8::Gemm g{OA, wl + WL_AO, MP, DM, 1024}; pg8::StaticOrder S; S.init(DM, 1024, C.G, C.bid, 0, 0, 16);
                EpiGateK E{P, XN};
                pg8::gemm_phase<EpiGateK, true>(C.lds, g, S, E, C.tid);
            } else if (k == 10 && EN(10)) {
                norm_phase<false>(C, H, HS, p->ffn2_norm + l * DM, XN, nullptr, nullptr, PART, 4, 1.0f, HS);
            }
        }
        { const int kk_ = ph == 0 ? 13 : (ph - 1) % 13;
          if (rep == 0 && ((REPMASK >> kk_) & 1)) { rep = 1; xcd_barrier(xbar); continue; } }
        rep = 0; ++ph;
        if (ph < ph_hi) { if (ph == 1) grid.sync(); else xcd_barrier(xbar); }
    }
}

extern "C" void kernel_launch(void* const* d_in, const int* in_sizes, int n_in, void* d_out, int out_size, void* d_ws, size_t ws_size, hipStream_t stream) {
    static int grid = 0;
    if (grid == 0) {
        if (n_in != 24 || ws_size < WS_END) { fprintf(stderr, "kernel_launch: unexpected n_in %d / ws_size %zu (need %zu)\n", n_in, ws_size, (size_t)WS_END); grid = -1; return; }
        int dev = 0, cus = 0, per_cu = 0;
        hipGetDevice(&dev);
        hipDeviceGetAttribute(&cus, hipDeviceAttributeMultiprocessorCount, dev);
        if (hipFuncSetAttribute((const void*)fwd_megakernel, hipFuncAttributeMaxDynamicSharedMemorySize, LDS_BYTES) != hipSuccess) { fprintf(stderr, "hipFuncSetAttribute failed\n"); grid = -1; return; }
        hipOccupancyMaxActiveBlocksPerMultiprocessor(&per_cu, (const void*)fwd_megakernel, 512, LDS_BYTES);
        (void)hipGetLastError();
        if (per_cu < 1) per_cu = 1;
        grid = cus;
    }
    if (grid < 0) return;
    if (hipMemsetAsync((char*)d_ws + WS_BAR, 0, 16384, stream) != hipSuccess) { fprintf(stderr, "memset failed\n"); return; }
    Params p{};
    const float* const* in = (const float* const*)d_in;
    p.x_prompt = in[0]; p.x_sample = in[1]; p.cache_k = in[2]; p.cache_v = in[3]; p.state_dn = in[4]; p.state_conv = in[5];
    p.ffn1_norm = in[6]; p.ffn1_gu = in[7]; p.ffn1_dn = in[8]; p.mix_norm = in[9]; p.w_in = in[10]; p.q_norm = in[11]; p.k_norm = in[12];
    p.sinks = in[13]; p.conv_w = in[14]; p.A_log = in[15]; p.dt_bias = in[16]; p.dn_out_norm = in[17]; p.w_attn_o = in[18]; p.w_dn_o = in[19];
    p.w_out = in[20]; p.ffn2_norm = in[21]; p.ffn2_gu = in[22]; p.ffn2_dn = in[23];
    p.out = (float*)d_out; p.ws = (unsigned char*)d_ws;
    int ph_lo = 0, ph_hi = NPH;
    void* args[] = {&p, &ph_lo, &ph_hi};
    hipError_t e = hipLaunchCooperativeKernel((const void*)fwd_megakernel, dim3(grid), dim3(512), args, LDS_BYTES, stream);
    if (e != hipSuccess) fprintf(stderr, "cooperative launch failed: %s (grid %d)\n", hipGetErrorString(e), grid);
}
```

```cpp
#include <hip/hip_runtime.h>
#include <hip/hip_cooperative_groups.h>
#include <cstdio>
#include <cstdint>
namespace cg = cooperative_groups;
#ifndef SUBREP
#define SUBREP 0
#endif

#define LAS __attribute__((address_space(3)))
typedef unsigned short bf16_t;
typedef short bf16x8 __attribute__((ext_vector_type(8)));
typedef float f32x4 __attribute__((ext_vector_type(4)));
typedef unsigned u32x4 __attribute__((ext_vector_type(4)));
typedef unsigned u32x2 __attribute__((ext_vector_type(2)));

constexpr int TP = 16384, TS = 128, TT = TP + TS, MP = 16640;
constexpr int DM = 1024, FF = 2816, NIN = 4864, NINSRC = 4872, DEPTH = 4;
constexpr float EPS = 1e-6f;
constexpr int PC_Q = 0, PC_K = 512, PC_V = 640, PC_RAW = 768, PC_Z = 2304, PC_GA = 2816, PC_GD = 3840;
constexpr size_t O_YP = 0, O_YS = 16777216, O_KP = 16908288, O_VP = 17432576, O_DNP = 17956864, O_CVP = 20054016,
                 O_KS = 20201472, O_VS = 28590080, O_DNS = 36978688, O_CVS = 70533120;
constexpr size_t WL_GU1 = 0, WL_DN1 = WL_GU1 + (size_t)5632 * 1024, WL_WIN = WL_DN1 + (size_t)1024 * 2816, WL_AO = WL_WIN + (size_t)NIN * 1024,
                 WL_DO = WL_AO + (size_t)1024 * 512, WL_WO = WL_DO + (size_t)1024 * 512, WL_GU2 = WL_WO + (size_t)1024 * 1024,
                 WL_DN2 = WL_GU2 + (size_t)5632 * 1024, WL_END = WL_DN2 + (size_t)1024 * 2816;
constexpr size_t MiB = 1u << 20;
constexpr size_t WS_ROPE = 0;
constexpr size_t WS_BG = 1 * MiB;
constexpr size_t WS_GL = 2 * MiB;
constexpr size_t WS_BAR = 2 * MiB + 65536;
constexpr size_t WS_W = 3 * MiB;
constexpr size_t WS_H = WS_W + ((WL_END * 2 * DEPTH + MiB - 1) / MiB) * MiB;
constexpr size_t WS_XN = WS_H + (size_t)MP * DM * 4;
constexpr size_t WS_ACT = WS_XN + (size_t)MP * DM * 2;
constexpr size_t WS_P = WS_ACT + (size_t)MP * FF * 2;
constexpr size_t WS_OA = WS_P + (size_t)MP * NIN * 2;
constexpr size_t WS_OD = WS_OA + (size_t)MP * 512 * 2;
constexpr size_t WS_ODF = WS_OD + (size_t)MP * 512 * 2;
constexpr size_t WS_PART = WS_ODF + (size_t)TP * 512 * 4;
constexpr size_t WS_END = WS_PART + (size_t)11 * TS * DM * 4;
constexpr size_t WS_UT = WS_ACT;
constexpr size_t WS_WN = WS_UT + (size_t)1024 * 8192 * 4;
constexpr size_t WS_QD = WS_WN + (size_t)1024 * 8192 * 2;
constexpr size_t WS_KDT = WS_QD + (size_t)1024 * 8192 * 2;
constexpr size_t WS_QK = WS_KDT + (size_t)1024 * 8192 * 2;
static_assert(WS_QK + (size_t)1024 * 4096 * 2 <= WS_P, "deltanet overlay fits in ACT");
static_assert((size_t)MP * DM * 4 <= (size_t)MP * FF * 2, "TMP fits in ACT");

constexpr int LDS_BYTES = 147456;

struct Params {
    const float* x_prompt; const float* x_sample; const float* cache_k; const float* cache_v; const float* state_dn; const float* state_conv;
    const float* ffn1_norm; const float* ffn1_gu; const float* ffn1_dn; const float* mix_norm; const float* w_in; const float* q_norm; const float* k_norm;
    const float* sinks; const float* conv_w; const float* A_log; const float* dt_bias; const float* dn_out_norm; const float* w_attn_o; const float* w_dn_o;
    const float* w_out; const float* ffn2_norm; const float* ffn2_gu; const float* ffn2_dn;
    float* out; unsigned char* ws;
};

__device__ __forceinline__ unsigned pk2(float lo, float hi);
__device__ __forceinline__ unsigned f2bf(float f) { return pk2(f, 0.f) & 0xffffu; }
typedef float f32x2_t __attribute__((ext_vector_type(2)));
typedef __bf16 bf16x2_t __attribute__((ext_vector_type(2)));
__device__ __forceinline__ unsigned pk2(float lo, float hi) { const f32x2_t v = {lo, hi}; const bf16x2_t b = __builtin_convertvector(v, bf16x2_t); return __builtin_bit_cast(unsigned, b); }
__device__ __forceinline__ float bflo(unsigned w) { return __uint_as_float(w << 16); }
__device__ __forceinline__ float bfhi(unsigned w) { return __uint_as_float(w & 0xffff0000u); }
__device__ __forceinline__ float bf1(bf16_t v) { return __uint_as_float(((unsigned)v) << 16); }
__device__ __forceinline__ float sigmoidf_(float x) { return __builtin_amdgcn_rcpf(1.0f + __expf(-x)); }
__device__ __forceinline__ float siluf_(float x) { return x * __builtin_amdgcn_rcpf(1.0f + __expf(-x)); }
__device__ __forceinline__ float softplusf_(float x) { return x > 20.f ? x : log1pf(__expf(x)); }

namespace pg8 {
constexpr int BM = 256, BK = 64, HALF = 128, HTB = HALF * BK * 2, NXCD = 8, WGM = 8;
__host__ __device__ __forceinline__ int lds_byte(int r, int c) { const int st = (r >> 4) * 2 + (c >> 5), rr = r & 15, cc = c & 31, ob = rr * 64 + cc * 2; return st * 1024 + (ob ^ (((ob >> 9) & 1) << 5)); }
__host__ __device__ __forceinline__ void stage_rc(int b, int& R, int& C) { const int st = b / 1024, sb = b % 1024, swz = sb ^ (((sb >> 9) & 1) << 5); R = (st >> 1) * 16 + swz / 64; C = (st & 1) * 32 + (swz % 64) / 2; }
struct Unit { int pm, pn, k0, nt; };
struct Gemm { const bf16_t* A; const bf16_t* Bt; int M, N, K; };
struct StaticOrder {
    int nM, nN, nwg, G, c, ntMain, extraBase, nExtra, extraNt;
    __device__ void init(int N, int K, int G_, int c_, int extraBase_, int nExtra_, int extraNt_) { nM = 64; nN = N / BM; nwg = nM * nN; G = G_; c = c_; ntMain = K / BK; extraBase = extraBase_; nExtra = nExtra_; extraNt = extraNt_; }
    __device__ bool next(int i, Unit& u) const {
        const long L = (long)i * G + c;
        if (L < nwg) {
            int wgid = (int)L; { const int q = nwg / NXCD, r = nwg % NXCD, xcd = wgid % NXCD, off = wgid / NXCD; wgid = (xcd < r ? xcd * (q + 1) : r * (q + 1) + (xcd - r) * q) + off; }
            const int nig = WGM * nN, gid = wgid / nig, fm = gid * WGM, gsz = (nM - fm) < WGM ? (nM - fm) : WGM;
            u.pm = fm + ((wgid % nig) % gsz); u.pn = (wgid % nig) / gsz; u.k0 = 0; u.nt = ntMain; return true;
        }
        const int nc = (nwg - c + G - 1) / G, j = c - extraBase;
        if (i == nc && j >= 0 && j < nExtra) { u.pm = 64; u.pn = j % nN; u.k0 = (j / nN) * extraNt; u.nt = extraNt; return true; }
        return false;
    }
};
template <class Epi, bool HOOK = false>
__device__ __forceinline__ void gemm_phase(LAS unsigned char* lds, const Gemm g, const StaticOrder& S, const Epi& E, const int tid) {
    const int wid = __builtin_amdgcn_readfirstlane(tid >> 6), lane = tid & 63, wr = wid >> 2, wc = wid & 3, fr = lane & 15, fq = lane >> 4;
    const int K = g.K;
    unsigned voffA[2];
#pragma unroll
    for (int i = 0; i < 2; ++i) { int R, C; stage_rc(tid * 16 + i * 8192, R, C); voffA[i] = (unsigned)(R * K + C) * 2u; }
    const size_t kstep = (size_t)(BK * 2);
    const size_t hstep = (size_t)HALF * K * 2;
    const size_t tstep = 2 * hstep;
    const unsigned ldsw = (unsigned)wid * 1024u;
    const int aoff = lds_byte(wr * 64 + fr, fq * 8), boff = lds_byte(wc * 32 + fr, fq * 8);
#define PG8_SA(b, h) (((b) * 2 + (h)) * HTB)
#define PG8_SB(b, h) ((4 + (b) * 2 + (h)) * HTB)
#define PG8_STAGE(bufoff, gbase) do { _Pragma("unroll") for (int _i = 0; _i < 2; ++_i) \
        __builtin_amdgcn_global_load_lds((const unsigned*)((const char*)(gbase) + voffA[_i]), (LAS unsigned*)(lds + (bufoff) + ldsw + _i * 8192), 16, 0, 0); } while (0)
#define PG8_LDA(dst, b, h) do { _Pragma("unroll") for (int m = 0; m < 4; ++m) _Pragma("unroll") for (int k = 0; k < 2; ++k) dst[m][k] = *(const LAS bf16x8*)(lds + PG8_SA(b, h) + aoff + m * 2048 + k * 1024); } while (0)
#define PG8_LDB(dst, b, h) do { _Pragma("unroll") for (int n = 0; n < 2; ++n) _Pragma("unroll") for (int k = 0; k < 2; ++k) dst[n][k] = *(const LAS bf16x8*)(lds + PG8_SB(b, h) + boff + n * 2048 + k * 1024); } while (0)
#define PG8_MMA(ai, bj, At, Bt) do { __builtin_amdgcn_s_setprio(1); _Pragma("unroll") for (int m = 0; m < 4; ++m) _Pragma("unroll") for (int n = 0; n < 2; ++n) _Pragma("unroll") for (int k = 0; k < 2; ++k) \
        acc[ai][bj][m][n] = __builtin_amdgcn_mfma_f32_16x16x32_bf16(Bt[n][k], At[m][k], acc[ai][bj][m][n], 0, 0, 0); __builtin_amdgcn_s_setprio(0); } while (0)
#define PG8_WAIT_V(n) asm volatile("s_waitcnt vmcnt(" #n ")" ::: "memory")
#define PG8_WAIT_L(n) asm volatile("s_waitcnt lgkmcnt(" #n ")" ::: "memory")
#define PG8_BAR __builtin_amdgcn_s_barrier()
#define PG8_SCHED __builtin_amdgcn_sched_barrier(0)
    Unit cur, nxt; int ui = 0;
    if (!S.next(0, cur)) return;
    f32x4 acc[2][2][4][2];
#pragma unroll
    for (int a = 0; a < 2; ++a)
#pragma unroll
        for (int b = 0; b < 2; ++b)
#pragma unroll
            for (int m = 0; m < 4; ++m)
#pragma unroll
                for (int n = 0; n < 2; ++n) acc[a][b][m][n] = (f32x4){0.f, 0.f, 0.f, 0.f};
    bf16x8 At[4][2], B0[2][2], B1[2][2];
    const char* cA = (const char*)g.A + (size_t)cur.pm * tstep + (size_t)cur.k0 * kstep; const char* cB = (const char*)g.Bt + (size_t)cur.pn * tstep + (size_t)cur.k0 * kstep;
    PG8_STAGE(PG8_SB(0, 0), cB); PG8_STAGE(PG8_SB(0, 1), cB + hstep); PG8_STAGE(PG8_SA(0, 0), cA); PG8_STAGE(PG8_SA(0, 1), cA + hstep);
    if (wr == 1) PG8_BAR;
    PG8_WAIT_V(2); PG8_BAR;
    PG8_STAGE(PG8_SB(1, 0), cB + kstep); PG8_STAGE(PG8_SA(1, 0), cA + kstep); PG8_STAGE(PG8_SB(1, 1), cB + hstep + kstep);
    PG8_WAIT_V(6); PG8_BAR;
    for (;;) {
        const bool has_next = S.next(ui + 1, nxt);
        const char* nA = has_next ? (const char*)g.A + (size_t)nxt.pm * tstep + (size_t)nxt.k0 * kstep : cA; const char* nB = has_next ? (const char*)g.Bt + (size_t)nxt.pn * tstep + (size_t)nxt.k0 * kstep : cB;
        const int nt = cur.nt;
        for (int t = 0; t < nt; t += 2) {
            const bool last = (t == nt - 2);
            if constexpr (HOOK) if (t == 8) { int fr2 = fr, fq2 = fq; asm volatile("" : "+v"(fr2), "+v"(fq2)); E.mid(acc, cur, wr, wc, fr2, fq2); }
            const char* a1 = cA + (size_t)(t + 1) * kstep;
            const char* a2 = last ? nA : cA + (size_t)(t + 2) * kstep; const char* b2 = last ? nB : cB + (size_t)(t + 2) * kstep;
            const char* a3 = a2 + kstep; const char* b3 = b2 + kstep;
            PG8_LDB(B0, 0, 0); PG8_LDB(B1, 0, 1); PG8_SCHED; PG8_LDA(At, 0, 0); PG8_STAGE(PG8_SA(1, 1), a1 + hstep);
            PG8_WAIT_V(8); PG8_WAIT_L(0); PG8_BAR; PG8_MMA(0, 0, At, B0); PG8_MMA(0, 1, At, B1); PG8_BAR; PG8_SCHED;
            PG8_LDA(At, 0, 1); PG8_STAGE(PG8_SB(0, 0), b2); PG8_STAGE(PG8_SB(0, 1), b2 + hstep); PG8_STAGE(PG8_SA(0, 0), a2);
            PG8_WAIT_V(8); PG8_WAIT_L(0); PG8_BAR; PG8_MMA(1, 0, At, B0); PG8_MMA(1, 1, At, B1); PG8_BAR; PG8_SCHED;
            PG8_LDB(B0, 1, 0); PG8_LDB(B1, 1, 1); PG8_SCHED; PG8_LDA(At, 1, 0); PG8_STAGE(PG8_SA(0, 1), a2 + hstep);
            PG8_WAIT_V(8); PG8_WAIT_L(0); PG8_BAR; PG8_MMA(0, 0, At, B0); PG8_MMA(0, 1, At, B1); PG8_BAR; PG8_SCHED;
            PG8_LDA(At, 1, 1); PG8_STAGE(PG8_SB(1, 0), b3); PG8_STAGE(PG8_SB(1, 1), b3 + hstep); PG8_STAGE(PG8_SA(1, 0), a3);
            PG8_WAIT_V(8); PG8_WAIT_L(0); PG8_BAR; PG8_MMA(1, 0, At, B0); PG8_MMA(1, 1, At, B1); PG8_BAR; PG8_SCHED;
        }
        if (wr == 0) PG8_BAR;
        { int fr2 = fr, fq2 = fq; asm volatile("" : "+v"(fr2), "+v"(fq2)); E(acc, cur, wr, wc, fr2, fq2); }
        if (!has_next) break;
#pragma unroll
        for (int a = 0; a < 2; ++a)
#pragma unroll
            for (int b = 0; b < 2; ++b)
#pragma unroll
                for (int m = 0; m < 4; ++m)
#pragma unroll
                    for (int n = 0; n < 2; ++n) acc[a][b][m][n] = (f32x4){0.f, 0.f, 0.f, 0.f};
        cur = nxt; cA = nA; cB = nB; ++ui;
        if (wr == 1) PG8_BAR;
    }
    PG8_WAIT_V(0);
    PG8_BAR;
#undef PG8_SA
#undef PG8_SB
#undef PG8_STAGE
#undef PG8_LDA
#undef PG8_LDB
#undef PG8_MMA
#undef PG8_WAIT_V
#undef PG8_WAIT_L
#undef PG8_BAR
#undef PG8_SCHED
}
}

typedef f32x4 AccT[2][2][4][2];

struct EpiSwiglu {
    bf16_t* act;
    __device__ __forceinline__ void operator()(const AccT& acc, const pg8::Unit& u, int wr, int wc, int fr, int fq) const {
#pragma unroll
        for (int ai = 0; ai < 2; ++ai)
#pragma unroll
            for (int m = 0; m < 4; ++m) {
                const int row = u.pm * 256 + ai * 128 + wr * 64 + m * 16 + fr;
                bf16_t* rp = act + (size_t)row * FF + u.pn * 128 + wc * 32 + fq * 8;
                const f32x4 g0 = acc[ai][0][m][0], u0 = acc[ai][1][m][0], g1 = acc[ai][0][m][1], u1 = acc[ai][1][m][1];
                u32x4 w; w.x = pk2(siluf_(g0[0]) * u0[0], siluf_(g0[1]) * u0[1]); w.y = pk2(siluf_(g0[2]) * u0[2], siluf_(g0[3]) * u0[3]);
                w.z = pk2(siluf_(g1[0]) * u1[0], siluf_(g1[1]) * u1[1]); w.w = pk2(siluf_(g1[2]) * u1[2], siluf_(g1[3]) * u1[3]);
                *(u32x4*)rp = w;
            }
    }
};
struct EpiResid {
    const float* baseP; float* outP; float scale; float* part;
    __device__ __forceinline__ void operator()(const AccT& acc, const pg8::Unit& u, int wr, int wc, int fr, int fq) const {
        if (u.pm == 64) {
            float* pp = part + (size_t)(u.k0 / u.nt) * (TS * DM);
#pragma unroll
            for (int m = 0; m < 4; ++m) {
                const int r = wr * 64 + m * 16 + fr;
#pragma unroll
                for (int bj = 0; bj < 2; ++bj)
#pragma unroll
                    for (int n = 0; n < 2; ++n) *(f32x4*)(pp + (size_t)r * DM + u.pn * 256 + bj * 128 + wc * 32 + fq * 8 + n * 4) = acc[0][bj][m][n];
            }
            return;
        }
#pragma unroll
        for (int ai = 0; ai < 2; ++ai)
#pragma unroll
            for (int m = 0; m < 4; ++m) {
                const int row = u.pm * 256 + ai * 128 + wr * 64 + m * 16 + fr;
                const float* b = baseP + (size_t)row * DM;
                float* o = outP + (size_t)row * DM;
#pragma unroll
                for (int bj = 0; bj < 2; ++bj)
#pragma unroll
                    for (int n = 0; n < 2; ++n) {
                        const int col = u.pn * 256 + bj * 128 + wc * 32 + fq * 8 + n * 4;
                        const f32x4 bv = *(const f32x4*)(b + col);
                        *(f32x4*)(o + col) = bv + scale * acc[ai][bj][m][n];
                    }
            }
    }
};
template <bool SECOND> struct EpiGate {
    const bf16_t* P; float* tmp; bf16_t* mrg;
    __device__ __forceinline__ void operator()(const AccT& acc, const pg8::Unit& u, int wr, int wc, int fr, int fq) const {
#pragma unroll
        for (int ai = 0; ai < 2; ++ai)
#pragma unroll
            for (int m = 0; m < 4; ++m) {
                const int row = u.pm * 256 + ai * 128 + wr * 64 + m * 16 + fr;
                if (row >= TT) continue;
#pragma unroll
                for (int bj = 0; bj < 2; ++bj)
#pragma unroll
                    for (int n = 0; n < 2; ++n) {
                        const int col = u.pn * 256 + bj * 128 + wc * 32 + fq * 8 + n * 4;
                        const u32x2 gw = *(const u32x2*)(P + (size_t)row * NIN + (SECOND ? PC_GD : PC_GA) + col);
                        const f32x4 a = acc[ai][bj][m][n];
                        f32x4 v; v[0] = sigmoidf_(bflo(gw.x)) * a[0]; v[1] = sigmoidf_(bfhi(gw.x)) * a[1]; v[2] = sigmoidf_(bflo(gw.y)) * a[2]; v[3] = sigmoidf_(bfhi(gw.y)) * a[3];
                        float* tp = tmp + (size_t)row * DM + col;
                        if (!SECOND) { *(f32x4*)tp = v; }
                        else { const f32x4 t = *(const f32x4*)tp; v = v + t; u32x2 w; w.x = pk2(v[0], v[1]); w.y = pk2(v[2], v[3]); *(u32x2*)(mrg + (size_t)row * DM + col) = w; }
                    }
            }
    }
};
struct EpiGateK {
    const bf16_t* P; bf16_t* mrg;
    __device__ __forceinline__ void mid(AccT& acc, const pg8::Unit& u, int wr, int wc, int fr, int fq) const {
#pragma unroll
        for (int ai = 0; ai < 2; ++ai)
#pragma unroll
            for (int m = 0; m < 4; ++m) {
                const int row = u.pm * 256 + ai * 128 + wr * 64 + m * 16 + fr;
                if (row >= TT) continue;
#pragma unroll
                for (int bj = 0; bj < 2; ++bj) {
                    const int col = u.pn * 256 + bj * 128 + wc * 32 + fq * 8;
                    const u32x4 ga = *(const u32x4*)(P + (size_t)row * NIN + PC_GA + col), gd = *(const u32x4*)(P + (size_t)row * NIN + PC_GD + col);
                    const unsigned gaw[4] = {ga.x, ga.y, ga.z, ga.w}, gdw[4] = {gd.x, gd.y, gd.z, gd.w};
#pragma unroll
                    for (int q = 0; q < 4; ++q) {
                        const float ea0 = __expf(-bflo(gaw[q])), ea1 = __expf(-bfhi(gaw[q]));
                        const float ed0 = __expf(fminf(-bflo(gdw[q]), 60.f)), ed1 = __expf(fminf(-bfhi(gdw[q]), 60.f));
                        const float r0 = (1.0f + ed0) * __builtin_amdgcn_rcpf(1.0f + ea0), r1 = (1.0f + ed1) * __builtin_amdgcn_rcpf(1.0f + ea1);
                        acc[ai][bj][m][q >> 1][(q & 1) * 2 + 0] *= r0; acc[ai][bj][m][q >> 1][(q & 1) * 2 + 1] *= r1;
                    }
                }
                __builtin_amdgcn_sched_barrier(0);
            }
    }
    __device__ __forceinline__ void operator()(const AccT& acc, const pg8::Unit& u, int wr, int wc, int fr, int fq) const {
#pragma unroll
        for (int ai = 0; ai < 2; ++ai)
#pragma unroll
            for (int m = 0; m < 4; ++m) {
                const int row = u.pm * 256 + ai * 128 + wr * 64 + m * 16 + fr;
                if (row >= TT) continue;
#pragma unroll
                for (int bj = 0; bj < 2; ++bj) {
                    const int col = u.pn * 256 + bj * 128 + wc * 32 + fq * 8;
                    const u32x4 gd = *(const u32x4*)(P + (size_t)row * NIN + PC_GD + col);
                    const unsigned gdw[4] = {gd.x, gd.y, gd.z, gd.w};
                    unsigned ow[4];
#pragma unroll
                    for (int q = 0; q < 4; ++q) {
                        const float s0 = __builtin_amdgcn_rcpf(1.0f + __expf(fminf(-bflo(gdw[q]), 60.f))), s1 = __builtin_amdgcn_rcpf(1.0f + __expf(fminf(-bfhi(gdw[q]), 60.f)));
                        ow[q] = pk2(acc[ai][bj][m][q >> 1][(q & 1) * 2 + 0] * s0, acc[ai][bj][m][q >> 1][(q & 1) * 2 + 1] * s1);
                    }
                    *(u32x4*)(mrg + (size_t)row * DM + col) = (u32x4){ow[0], ow[1], ow[2], ow[3]};
                }
            }
    }
};
struct EpiWin {
    bf16_t* P; const float* qnw; const float* knw; const float2* rope;
    __device__ __forceinline__ void operator()(const AccT& acc, const pg8::Unit& u, int wr, int wc, int fr, int fq) const {
        const int tile = u.pn;
        const bool headed = tile <= 1 || (tile == 2 && wc < 2), isq = tile <= 1;
        const float* nw = isq ? qnw : knw;
        const float sc = isq ? 0.125f : 1.0f;
#pragma unroll
        for (int ai = 0; ai < 2; ++ai)
#pragma unroll
            for (int m = 0; m < 4; ++m) {
                const int row = u.pm * 256 + ai * 128 + wr * 64 + m * 16 + fr;
                const bool valid = row < TT;
                bf16_t* prow = P + (size_t)row * NIN + tile * 256 + wc * 64;
                if (headed) {
                    float ss = 0.f;
#pragma unroll
                    for (int bj = 0; bj < 2; ++bj)
#pragma unroll
                        for (int n = 0; n < 2; ++n) { const f32x4 a = acc[ai][bj][m][n]; ss += a[0] * a[0] + a[1] * a[1] + a[2] * a[2] + a[3] * a[3]; }
                    ss += __shfl_xor(ss, 16); ss += __shfl_xor(ss, 32);
                    if (!valid) continue;
                    const float rs = rsqrtf(ss * (1.0f / 64.0f) + EPS);
                    const float2* rp = rope + (size_t)(row < TP ? (row & 2047) : 2048) * 32;
#pragma unroll
                    for (int n = 0; n < 2; ++n) {
                        const int i0 = fq * 8 + n * 4;
                        const f32x4 w1 = *(const f32x4*)(nw + i0), w2 = *(const f32x4*)(nw + 32 + i0);
                        f32x4 o1, o2;
#pragma unroll
                        for (int j = 0; j < 4; ++j) {
                            const float x1 = acc[ai][0][m][n][j] * rs * w1[j], x2 = acc[ai][1][m][n][j] * rs * w2[j];
                            const float2 cs = rp[i0 + j];
                            o1[j] = (x1 * cs.x - x2 * cs.y) * sc; o2[j] = (x2 * cs.x + x1 * cs.y) * sc;
                        }
                        u32x2 a, b; a.x = pk2(o1[0], o1[1]); a.y = pk2(o1[2], o1[3]); b.x = pk2(o2[0], o2[1]); b.y = pk2(o2[2], o2[3]);
                        *(u32x2*)(prow + i0) = a; *(u32x2*)(prow + 32 + i0) = b;
                    }
                } else {
                    if (!valid) continue;
#pragma unroll
                    for (int bj = 0; bj < 2; ++bj)
#pragma unroll
                        for (int n = 0; n < 2; ++n) {
                            const f32x4 a = acc[ai][bj][m][n];
                            u32x2 w; w.x = pk2(a[0], a[1]); w.y = pk2(a[2], a[3]);
                            *(u32x2*)(prow + bj * 32 + fq * 8 + n * 4) = w;
                        }
                }
            }
    }
};

typedef const __attribute__((address_space(4))) Params* PK;
struct Ctx { LAS unsigned char* lds; int tid, lane, wave, G, bid; };

__device__ __forceinline__ int src_col(int type, int n0) {
    if (type == 0) return n0;
    const int tile = n0 >> 8, p = n0 & 255;
    if (type == 1) return p < 128 ? tile * 128 + p : FF + tile * 128 + (p - 128);
    const int bj = p >> 7, wc = (p >> 5) & 3, c32 = p & 31; const int lg = tile * 256 + wc * 64 + bj * 32 + c32;
    return lg < PC_GA ? lg : lg + 8;
}
__device__ __forceinline__ void convert_weight(const Ctx& C, const float* src, int ld, int K, int N, int type, bf16_t* dst, int dld = 0, int koff = 0) {
    if (dld == 0) dld = K;
    LAS float* tile = (LAS float*)C.lds;
    const int nnt = N / 32, nitems = nnt * (K / 256);
    const int c4 = (C.tid & 7) * 4, kr = C.tid >> 3;
    for (int it0 = C.bid; it0 < nitems; it0 += 2 * C.G) {
        f32x4 v[2][4];
#pragma unroll
        for (int u = 0; u < 2; ++u) {
            const int it = it0 + u * C.G;
            if (it < nitems) {
                const int ntile = it % nnt, kt = it / nnt, k0 = kt * 256, s0 = src_col(type, ntile * 32);
#pragma unroll
                for (int p = 0; p < 4; ++p) v[u][p] = *(const f32x4*)(src + (size_t)(k0 + p * 64 + kr) * ld + s0 + c4);
            }
        }
#pragma unroll
        for (int u = 0; u < 2; ++u)
            if (it0 + u * C.G < nitems) {
#pragma unroll
                for (int p = 0; p < 4; ++p) { LAS float* tp = tile + u * 8448 + (p * 64 + kr) * 33 + c4; tp[0] = v[u][p][0]; tp[1] = v[u][p][1]; tp[2] = v[u][p][2]; tp[3] = v[u][p][3]; }
            }
        __syncthreads();
#pragma unroll
        for (int u = 0; u < 2; ++u) {
            const int it = it0 + u * C.G;
            if (it < nitems) {
                const int ntile = it % nnt, kt = it / nnt, n0 = ntile * 32, k0 = kt * 256;
#pragma unroll
                for (int h2 = 0; h2 < 2; ++h2) {
                    const int n = C.tid >> 4, ks = (C.tid & 15) * 8 + h2 * 128;
                    const int ln = 8 * ((n >> 2) & 3) + 4 * (n >> 4) + (n & 3);
                    const LAS float* tb = tile + u * 8448;
                    u32x4 w;
                    w.x = pk2(tb[(ks + 0) * 33 + ln], tb[(ks + 1) * 33 + ln]); w.y = pk2(tb[(ks + 2) * 33 + ln], tb[(ks + 3) * 33 + ln]);
                    w.z = pk2(tb[(ks + 4) * 33 + ln], tb[(ks + 5) * 33 + ln]); w.w = pk2(tb[(ks + 6) * 33 + ln], tb[(ks + 7) * 33 + ln]);
                    *(u32x4*)(dst + (size_t)(n0 + n) * dld + koff + k0 + ks) = w;
                }
            }
        }
        __syncthreads();
    }
}

__device__ __forceinline__ float wave_sum(float v) {
#pragma unroll
    for (int o = 1; o < 64; o <<= 1) v += __shfl_xor(v, o);
    return v;
}

template <bool WITH_BG>
__device__ __forceinline__ void norm_phase(const Ctx& C, const float* inP, const float* inS, const float* w, bf16_t* xn, const float* win_l, float* bg, const float* part, int np, float pscale, float* soutS) {
    float wb[16][8];
    if (WITH_BG) {
#pragma unroll
        for (int c = 0; c < 4; ++c)
#pragma unroll
            for (int e = 0; e < 4; ++e) {
                const float* wp = win_l + (size_t)(c * 256 + C.lane * 4 + e) * NINSRC + 2816;
                const f32x4 a = *(const f32x4*)wp, b = *(const f32x4*)(wp + 4);
                wb[c * 4 + e][0] = a[0]; wb[c * 4 + e][1] = a[1]; wb[c * 4 + e][2] = a[2]; wb[c * 4 + e][3] = a[3];
                wb[c * 4 + e][4] = b[0]; wb[c * 4 + e][5] = b[1]; wb[c * 4 + e][6] = b[2]; wb[c * 4 + e][7] = b[3];
            }
    }
    f32x4 nv[4];
    { const int row = C.bid * 8 + C.wave;
      if (row < TT) { const float* x = row < TP ? inP + (size_t)row * DM : inS + (size_t)(row - TP) * DM;
#pragma unroll
        for (int c = 0; c < 4; ++c) nv[c] = *(const f32x4*)(x + c * 256 + C.lane * 4); } }
    for (int row = C.bid * 8 + C.wave; row < TT; row += C.G * 8) {
        f32x4 v[4]; float ss = 0.f;
#pragma unroll
        for (int c = 0; c < 4; ++c) v[c] = nv[c];
        { const int r2 = row + C.G * 8;
          if (r2 < TT) { const float* x2 = r2 < TP ? inP + (size_t)r2 * DM : inS + (size_t)(r2 - TP) * DM;
#pragma unroll
            for (int c = 0; c < 4; ++c) nv[c] = *(const f32x4*)(x2 + c * 256 + C.lane * 4); } }
        if (row >= TP && np > 0) {
            f32x4 a[4];
#pragma unroll
            for (int c = 0; c < 4; ++c) a[c] = (f32x4){0.f, 0.f, 0.f, 0.f};
            for (int i = 0; i < np; ++i) {
                const float* pp = part + ((size_t)i * TS + (row - TP)) * DM + C.lane * 4;
#pragma unroll
                for (int c = 0; c < 4; ++c) a[c] += *(const f32x4*)(pp + c * 256);
            }
#pragma unroll
            for (int c = 0; c < 4; ++c) { v[c] += pscale * a[c]; *(f32x4*)(soutS + (size_t)(row - TP) * DM + c * 256 + C.lane * 4) = v[c]; }
        }
#pragma unroll
        for (int c = 0; c < 4; ++c) ss += v[c][0] * v[c][0] + v[c][1] * v[c][1] + v[c][2] * v[c][2] + v[c][3] * v[c][3];
        ss = wave_sum(ss);
        const float rs = rsqrtf(ss * (1.0f / 1024.0f) + EPS);
        float d[8];
        if (WITH_BG) {
#pragma unroll
            for (int q = 0; q < 8; ++q) d[q] = 0.f;
        }
#pragma unroll
        for (int c = 0; c < 4; ++c) {
            const f32x4 wv = *(const f32x4*)(w + c * 256 + C.lane * 4);
            f32x4 y = v[c] * rs * wv;
            u32x2 o; o.x = pk2(y[0], y[1]); o.y = pk2(y[2], y[3]);
            *(u32x2*)(xn + (size_t)row * DM + c * 256 + C.lane * 4) = o;
            if (WITH_BG) {
#pragma unroll
                for (int e = 0; e < 4; ++e)
#pragma unroll
                    for (int q = 0; q < 8; ++q) d[q] += y[e] * wb[c * 4 + e][q];
            }
        }
        if (WITH_BG) {
#pragma unroll
            for (int q = 0; q < 8; ++q) d[q] = wave_sum(d[q]);
            if (C.lane == 0) { *(f32x4*)(bg + (size_t)row * 8) = (f32x4){d[0], d[1], d[2], d[3]}; *(f32x4*)(bg + (size_t)row * 8 + 4) = (f32x4){d[4], d[5], d[6], d[7]}; }
        }
    }
}

__device__ __forceinline__ void finalize_od(const Ctx& C, const float* odf, const bf16_t* P, const float* onw, bf16_t* od) {
    const int e0 = (C.lane & 15) * 8;
    const f32x4 w0 = *(const f32x4*)(onw + e0), w1 = *(const f32x4*)(onw + e0 + 4);
    f32x4 na, nb; u32x4 nz;
    { const int row = C.bid * 8 + C.wave;
      if (row < TP) { const float* op = odf + (size_t)row * 512 + C.lane * 8; na = *(const f32x4*)op; nb = *(const f32x4*)(op + 4); nz = *(const u32x4*)(P + (size_t)row * NIN + PC_Z + C.lane * 8); } }
    for (int row = C.bid * 8 + C.wave; row < TP; row += C.G * 8) {
        const f32x4 a = na, b = nb; const u32x4 z = nz;
        { const int r2 = row + C.G * 8;
          if (r2 < TP) { const float* op = odf + (size_t)r2 * 512 + C.lane * 8; na = *(const f32x4*)op; nb = *(const f32x4*)(op + 4); nz = *(const u32x4*)(P + (size_t)r2 * NIN + PC_Z + C.lane * 8); } }
        float ss = a[0] * a[0] + a[1] * a[1] + a[2] * a[2] + a[3] * a[3] + b[0] * b[0] + b[1] * b[1] + b[2] * b[2] + b[3] * b[3];
        ss += __shfl_xor(ss, 1); ss += __shfl_xor(ss, 2); ss += __shfl_xor(ss, 4); ss += __shfl_xor(ss, 8);
        const float rs = rsqrtf(ss * (1.0f / 128.0f) + EPS);
        u32x4 o;
        o.x = pk2(a[0] * rs * w0[0] * siluf_(bflo(z.x)), a[1] * rs * w0[1] * siluf_(bfhi(z.x)));
        o.y = pk2(a[2] * rs * w0[2] * siluf_(bflo(z.y)), a[3] * rs * w0[3] * siluf_(bfhi(z.y)));
        o.z = pk2(b[0] * rs * w1[0] * siluf_(bflo(z.z)), b[1] * rs * w1[1] * siluf_(bfhi(z.z)));
        o.w = pk2(b[2] * rs * w1[2] * siluf_(bflo(z.w)), b[3] * rs * w1[3] * siluf_(bfhi(z.w)));
        *(u32x4*)(od + (size_t)row * 1024 + 512 + C.lane * 8) = o;
    }
}

__device__ __forceinline__ void attn_prompt_unit(const Ctx& C, int unit, const bf16_t* P, const float* sinks_l, bf16_t* OA) {
    const int kvh = unit & 1, qb = (unit >> 1) & 15, b = unit >> 5;
    LAS unsigned char* Ks = C.lds;
    LAS unsigned char* Vt = C.lds + 36864;
    const int tok0 = b * 2048 + qb * 128 - 128;
    bf16x8 qfa[2][2][2];
    {
        const int g_ = C.wave >> 1, hq_ = C.wave & 1, h_ = kvh * 4 + g_, fr_ = C.lane & 15, fq_ = C.lane >> 4;
#pragma unroll
        for (int it = 0; it < 2; ++it)
#pragma unroll
            for (int qt = 0; qt < 2; ++qt)
#pragma unroll
                for (int kk = 0; kk < 2; ++kk)
                    qfa[it][qt][kk] = *(const bf16x8*)(P + (size_t)(b * 2048 + qb * 128 + hq_ * 64 + it * 32 + qt * 16 + fr_) * NIN + PC_Q + h_ * 64 + kk * 32 + fq_ * 8);
    }
#pragma unroll
    for (int p = 0; p < 4; ++p) {
        const int id = C.tid + p * 512, r = id >> 3, ch = id & 7;
        const bool ok = (qb > 0) || (r >= 128);
        u32x4 kv = (u32x4){0u, 0u, 0u, 0u}, vv = (u32x4){0u, 0u, 0u, 0u};
        if (ok) { const bf16_t* rp = P + (size_t)(tok0 + r) * NIN; kv = *(const u32x4*)(rp + PC_K + kvh * 64 + ch * 8); vv = *(const u32x4*)(rp + PC_V + kvh * 64 + ch * 8); }
        *(LAS u32x4*)(Ks + r * 144 + ch * 16) = kv;
        LAS bf16_t* vt = (LAS bf16_t*)(Vt + (ch * 8) * 528 + r * 2);
        vt[0 * 264] = (bf16_t)(vv.x & 0xffff); vt[1 * 264] = (bf16_t)(vv.x >> 16); vt[2 * 264] = (bf16_t)(vv.y & 0xffff); vt[3 * 264] = (bf16_t)(vv.y >> 16);
        vt[4 * 264] = (bf16_t)(vv.z & 0xffff); vt[5 * 264] = (bf16_t)(vv.z >> 16); vt[6 * 264] = (bf16_t)(vv.w & 0xffff); vt[7 * 264] = (bf16_t)(vv.w >> 16);
    }
    __syncthreads();
    const int g = C.wave >> 1, hq = C.wave & 1, h = kvh * 4 + g, fr = C.lane & 15, fq = C.lane >> 4;
    const float sink = sinks_l[h];
#pragma unroll 1
    for (int it = 0; it < 2; ++it) {
        const int tq0 = hq * 64 + it * 32, jb0 = tq0;
        bf16x8 qf[2][2];
#pragma unroll
        for (int qt = 0; qt < 2; ++qt)
#pragma unroll
            for (int kk = 0; kk < 2; ++kk) qf[qt][kk] = it == 0 ? qfa[0][qt][kk] : qfa[1][qt][kk];
        f32x4 st[2][10];
#pragma unroll
        for (int kt = 0; kt < 10; ++kt) {
            st[0][kt] = (f32x4){0.f, 0.f, 0.f, 0.f}; st[1][kt] = (f32x4){0.f, 0.f, 0.f, 0.f};
#pragma unroll
            for (int kk = 0; kk < 2; ++kk) {
                const bf16x8 kf = *(const LAS bf16x8*)(Ks + (jb0 + kt * 16 + fr) * 144 + (kk * 32 + fq * 8) * 2);
                st[0][kt] = __builtin_amdgcn_mfma_f32_16x16x32_bf16(kf, qf[0][kk], st[0][kt], 0, 0, 0);
                st[1][kt] = __builtin_amdgcn_mfma_f32_16x16x32_bf16(kf, qf[1][kk], st[1][kt], 0, 0, 0);
            }
        }
        bf16x8 pb[2][5]; float linv[2];
#pragma unroll
        for (int qt = 0; qt < 2; ++qt) {
            const int tq = tq0 + qt * 16 + fr;
            float mx = sink;
#pragma unroll
            for (int kt = 0; kt < 10; ++kt)
#pragma unroll
                for (int j = 0; j < 4; ++j) {
                    const int jb = jb0 + kt * 16 + fq * 4 + j, rel = 128 + tq - jb;
                    const bool ok = rel >= 0 && rel <= 128 && (qb > 0 || jb >= 128);
                    const float s = ok ? st[qt][kt][j] : -INFINITY;
                    st[qt][kt][j] = s; mx = fmaxf(mx, s);
                }
            mx = fmaxf(mx, __shfl_xor(mx, 16)); mx = fmaxf(mx, __shfl_xor(mx, 32));
            float l = 0.f;
#pragma unroll
            for (int kt = 0; kt < 10; ++kt)
#pragma unroll
                for (int j = 0; j < 4; ++j) { const float p = __expf(st[qt][kt][j] - mx); st[qt][kt][j] = p; l += p; }
            l += __shfl_xor(l, 16); l += __shfl_xor(l, 32);
            l += __expf(sink - mx);
            linv[qt] = 1.0f / l;
#pragma unroll
            for (int sl = 0; sl < 5; ++sl) {
                const f32x4 p0 = st[qt][2 * sl], p1 = st[qt][2 * sl + 1];
                u32x4 w; w.x = pk2(p0[0], p0[1]); w.y = pk2(p0[2], p0[3]); w.z = pk2(p1[0], p1[1]); w.w = pk2(p1[2], p1[3]);
                pb[qt][sl] = __builtin_bit_cast(bf16x8, w);
            }
        }
        f32x4 ot[2][4];
#pragma unroll
        for (int dt = 0; dt < 4; ++dt) { ot[0][dt] = (f32x4){0.f, 0.f, 0.f, 0.f}; ot[1][dt] = (f32x4){0.f, 0.f, 0.f, 0.f}; }
#pragma unroll
        for (int sl = 0; sl < 5; ++sl)
#pragma unroll
            for (int dt = 0; dt < 4; ++dt) {
                const LAS unsigned char* vp = Vt + (dt * 16 + fr) * 528 + (jb0 + sl * 32 + fq * 4) * 2;
                const u32x2 v0 = *(const LAS u32x2*)vp, v1 = *(const LAS u32x2*)(vp + 32);
                const u32x4 vw = (u32x4){v0.x, v0.y, v1.x, v1.y};
                const bf16x8 vf = __builtin_bit_cast(bf16x8, vw);
                ot[0][dt] = __builtin_amdgcn_mfma_f32_16x16x32_bf16(vf, pb[0][sl], ot[0][dt], 0, 0, 0);
                ot[1][dt] = __builtin_amdgcn_mfma_f32_16x16x32_bf16(vf, pb[1][sl], ot[1][dt], 0, 0, 0);
            }
#pragma unroll
        for (int qt = 0; qt < 2; ++qt) {
            bf16_t* op = OA + (size_t)(b * 2048 + qb * 128 + tq0 + qt * 16 + fr) * 1024 + h * 64 + fq * 4;
#pragma unroll
            for (int dt = 0; dt < 4; ++dt) {
                const f32x4 o = ot[qt][dt] * linv[qt];
                u32x2 w; w.x = pk2(o[0], o[1]); w.y = pk2(o[2], o[3]);
                *(u32x2*)(op + dt * 16) = w;
            }
        }
    }
    __syncthreads();
}

__device__ __forceinline__ void attn_sample_task(const Ctx& C, int task, int l, PK p, const bf16_t* P, bf16_t* OA) {
    const int b = task >> 3, h = task & 7, kvh = h >> 2, lane = C.lane;
    const size_t row = (size_t)TP + b;
    const float* ck = p->cache_k + ((size_t)(l * 128 + b) * 128) * 128 + kvh * 64;
    const float* cv = p->cache_v + ((size_t)(l * 128 + b) * 128) * 128 + kvh * 64;
    u32x4 qw[8];
#pragma unroll
    for (int i = 0; i < 8; ++i) qw[i] = *(const u32x4*)(P + row * NIN + PC_Q + h * 64 + i * 8);
    float s0 = 0.f, s1 = 0.f, s2 = 0.f;
    {
        const float* k0 = ck + (size_t)lane * 128; const float* k1 = ck + (size_t)(lane + 64) * 128;
#pragma unroll
        for (int i = 0; i < 8; ++i) {
            const f32x4 a0 = *(const f32x4*)(k0 + i * 8), a1 = *(const f32x4*)(k0 + i * 8 + 4), b0 = *(const f32x4*)(k1 + i * 8), b1 = *(const f32x4*)(k1 + i * 8 + 4);
            const float q0 = bflo(qw[i].x), q1 = bfhi(qw[i].x), q2 = bflo(qw[i].y), q3 = bfhi(qw[i].y), q4 = bflo(qw[i].z), q5 = bfhi(qw[i].z), q6 = bflo(qw[i].w), q7 = bfhi(qw[i].w);
            s0 += q0 * a0[0] + q1 * a0[1] + q2 * a0[2] + q3 * a0[3] + q4 * a1[0] + q5 * a1[1] + q6 * a1[2] + q7 * a1[3];
            s1 += q0 * b0[0] + q1 * b0[1] + q2 * b0[2] + q3 * b0[3] + q4 * b1[0] + q5 * b1[1] + q6 * b1[2] + q7 * b1[3];
            const u32x4 kn = *(const u32x4*)(P + row * NIN + PC_K + kvh * 64 + i * 8);
            s2 += q0 * bflo(kn.x) + q1 * bfhi(kn.x) + q2 * bflo(kn.y) + q3 * bfhi(kn.y) + q4 * bflo(kn.z) + q5 * bfhi(kn.z) + q6 * bflo(kn.w) + q7 * bfhi(kn.w);
        }
    }
    const float sink = p->sinks[l * 8 + h];
    float mx = fmaxf(fmaxf(s0, s1), fmaxf(s2, sink));
#pragma unroll
    for (int o = 1; o < 64; o <<= 1) mx = fmaxf(mx, __shfl_xor(mx, o));
    const float p0 = __expf(s0 - mx), p1 = __expf(s1 - mx), p2 = __expf(s2 - mx);
    const float lsum = wave_sum(p0 + p1) + p2 + __expf(sink - mx);
    float o = p2 * bf1(P[row * NIN + PC_V + kvh * 64 + lane]);
    for (int j = 0; j < 64; ++j) {
        const float pa = __shfl(p0, j), pbv = __shfl(p1, j);
        o += pa * cv[(size_t)j * 128 + lane] + pbv * cv[(size_t)(j + 64) * 128 + lane];
    }
    OA[row * 1024 + h * 64 + lane] = (bf16_t)f2bf(o / lsum);
    if ((h & 3) == 0) {
        float* ok = p->out + O_KS + ((size_t)(l * 128 + b) * 128) * 128 + kvh * 64;
        float* ov = p->out + O_VS + ((size_t)(l * 128 + b) * 128) * 128 + kvh * 64;
        for (int j = 0; j < 127; ++j) { ok[(size_t)j * 128 + lane] = ck[(size_t)(j + 1) * 128 + lane]; ov[(size_t)j * 128 + lane] = cv[(size_t)(j + 1) * 128 + lane]; }
        ok[(size_t)127 * 128 + lane] = bf1(P[row * NIN + PC_K + kvh * 64 + lane]); ov[(size_t)127 * 128 + lane] = bf1(P[row * NIN + PC_V + kvh * 64 + lane]);
    }
}

__device__ __forceinline__ void dn_sample_task(const Ctx& C, int task, int l, PK p, const bf16_t* P, const float* BG, bf16_t* OD) {
    const int b = task >> 2, h = task & 3, tid = C.tid;
    const size_t row = (size_t)TP + b;
    LAS float* sq = (LAS float*)C.lds;
    LAS float* red = sq + 384;
    LAS float* scal = red + 512;
    const float* sc = p->state_conv + (size_t)(l * 128 + b) * 3 * 1536;
    float s[32];
    {
        const float* S0h = p->state_dn + ((size_t)(l * 128 + b) * 4 + h) * 16384 + (size_t)(tid >> 7) * 32 * 128 + (tid & 127);
#pragma unroll
        for (int dd = 0; dd < 32; ++dd) s[dd] = S0h[(size_t)dd * 128];
    }
    if (tid < 384) {
        const int which = tid >> 7, ch = tid & 127, c = which * 512 + h * 128 + ch;
        const float* cw = p->conv_w + (size_t)l * 4 * 1536 + c;
        const float x0 = sc[c], x1 = sc[1536 + c], x2 = sc[3072 + c], x3 = bf1(P[row * NIN + PC_RAW + c]);
        const float y = x0 * cw[0] + x1 * cw[1536] + x2 * cw[3072] + x3 * cw[4608];
        sq[which * 128 + ch] = siluf_(y);
        float* oc = p->out + O_CVS + (size_t)(l * 128 + b) * 3 * 1536;
        oc[c] = x1; oc[1536 + c] = x2; oc[3072 + c] = x3;
    }
    __syncthreads();
    if (C.wave < 2) {
        const float a = sq[C.wave * 128 + C.lane], bq = sq[C.wave * 128 + 64 + C.lane];
        const float ssum = wave_sum(a * a + bq * bq);
        if (C.lane == 0) scal[C.wave] = rsqrtf(ssum + EPS);
    }
    __syncthreads();
    const float qsc = scal[0] * 0.08838834764831845f, ksc = scal[1];
    const float beta = sigmoidf_(BG[row * 8 + h]);
    const float gdec = __expf(-__expf(p->A_log[l * 4 + h]) * softplusf_(BG[row * 8 + 4 + h] + p->dt_bias[l * 4 + h]));
    const int e = tid & 127, dq = tid >> 7;
    const float* S0 = p->state_dn + ((size_t)(l * 128 + b) * 4 + h) * 16384;
    float* So = p->out + O_DNS + ((size_t)(l * 128 + b) * 4 + h) * 16384;
    float pred = 0.f;
#pragma unroll
    for (int dd = 0; dd < 32; ++dd) { const int d = dq * 32 + dd; s[dd] *= gdec; pred += sq[128 + d] * ksc * s[dd]; }
    red[dq * 128 + e] = pred;
    __syncthreads();
    const float predt = red[e] + red[128 + e] + red[256 + e] + red[384 + e];
    const float delta = beta * (sq[256 + e] - predt);
    float o = 0.f;
#pragma unroll
    for (int dd = 0; dd < 32; ++dd) { const int d = dq * 32 + dd; s[dd] += sq[128 + d] * ksc * delta; So[(size_t)d * 128 + e] = s[dd]; o += sq[d] * qsc * s[dd]; }
    __syncthreads();
    red[dq * 128 + e] = o;
    __syncthreads();
    if (tid < 128) {
        const float ot = red[e] + red[128 + e] + red[256 + e] + red[384 + e];
        const float ssum = wave_sum(ot * ot);
        if (C.lane == 0) scal[2 + C.wave] = ssum;
        sq[e] = ot;
    }
    __syncthreads();
    if (tid < 128) {
        const float rs = rsqrtf((scal[2] + scal[3]) * (1.0f / 128.0f) + EPS);
        const float z = bf1(P[row * NIN + PC_Z + h * 128 + e]);
        OD[row * 1024 + 512 + h * 128 + e] = (bf16_t)f2bf(sq[e] * rs * p->dn_out_norm[l * 128 + e] * siluf_(z));
    }
    __syncthreads();
}

__device__ __forceinline__ void dn_pre_unit(const Ctx& C, int unit, int l, PK p, const bf16_t* P, const float* BG) {
    const int h = unit & 3, n = (unit >> 2) & 31, b = unit >> 7;
    const int tid = C.tid, lane = C.lane, w = C.wave, fr = lane & 15, fq = lane >> 4;
    LAS unsigned char* Ks = C.lds;
    LAS unsigned char* Qs = C.lds + 17408;
    LAS unsigned char* Vt = C.lds + 34816;
    LAS unsigned char* KtW = C.lds + 53248;
    LAS unsigned char* KdT = C.lds + 71680;
    LAS float* A2 = (LAS float*)(C.lds + 90112);
    LAS unsigned char* Ts = C.lds + 106496;
    LAS float* sG = (LAS float*)(C.lds + 115712);
    LAS float* sB = sG + 64;
    unsigned char* ws = p->ws;
    float* UT = (float*)(ws + WS_UT) + (size_t)unit * 8192;
    bf16_t* WN = (bf16_t*)(ws + WS_WN) + (size_t)unit * 8192;
    bf16_t* QD = (bf16_t*)(ws + WS_QD) + (size_t)unit * 8192;
    bf16_t* KDT = (bf16_t*)(ws + WS_KDT) + (size_t)unit * 8192;
    bf16_t* QK = (bf16_t*)(ws + WS_QK) + (size_t)unit * 4096;
    const int row0 = b * 2048 + n * 64;
    u32x4 pre[2][4][2];
    {
        const int t = tid >> 3, ch0 = (tid & 7) * 16;
#pragma unroll
        for (int which = 0; which < 2; ++which)
#pragma unroll
            for (int i = 0; i < 4; ++i) {
                const int tt = n * 64 + t - 3 + i;
                pre[which][i][0] = (u32x4){0u, 0u, 0u, 0u}; pre[which][i][1] = (u32x4){0u, 0u, 0u, 0u};
                if (tt >= 0) { const bf16_t* rp = P + (size_t)(b * 2048 + tt) * NIN + PC_RAW + which * 512 + h * 128 + ch0; pre[which][i][0] = *(const u32x4*)rp; pre[which][i][1] = *(const u32x4*)(rp + 8); }
            }
    }
    if (w == 0) {
        const float bb = BG[(size_t)(row0 + lane) * 8 + h], aa = BG[(size_t)(row0 + lane) * 8 + 4 + h];
        const float beta = sigmoidf_(bb);
        float gsum = -__expf(p->A_log[l * 4 + h]) * softplusf_(aa + p->dt_bias[l * 4 + h]);
#pragma unroll
        for (int o = 1; o < 64; o <<= 1) { const float t = __shfl_up(gsum, o); if (lane >= o) gsum += t; }
        sG[lane] = gsum; sB[lane] = beta;
        if (lane == 63) ((float*)(ws + WS_GL))[unit] = __expf(gsum);
    }
    __syncthreads();
    for (int r2_ = 0; r2_ < 1 + ((SUBREP >> 8) & 1); ++r2_)
    {
        const int t = tid >> 3, ch0 = (tid & 7) * 16;
        const float Gt = sG[t], bt = sB[t], eG = __expf(Gt), eGl = __expf(sG[63] - Gt);
#pragma unroll
        for (int which = 0; which < 3; ++which) {
            const int c = which * 512 + h * 128 + ch0;
            float y[16];
#pragma unroll
            for (int q = 0; q < 16; ++q) y[q] = 0.f;
#pragma unroll
            for (int i = 0; i < 4; ++i) {
                const int tt = n * 64 + t - 3 + i;
                if (tt >= 0) {
                    u32x4 x0, x1;
                    if (which < 2) { x0 = pre[which < 2 ? which : 0][i][0]; x1 = pre[which < 2 ? which : 0][i][1]; }
                    else { const bf16_t* rp = P + (size_t)(b * 2048 + tt) * NIN + PC_RAW + c; x0 = *(const u32x4*)rp; x1 = *(const u32x4*)(rp + 8); }
                    const float* cw = p->conv_w + ((size_t)l * 4 + i) * 1536 + c;
                    const f32x4 w0 = *(const f32x4*)cw, w1 = *(const f32x4*)(cw + 4), w2 = *(const f32x4*)(cw + 8), w3 = *(const f32x4*)(cw + 12);
                    y[0] += bflo(x0.x) * w0[0]; y[1] += bfhi(x0.x) * w0[1]; y[2] += bflo(x0.y) * w0[2]; y[3] += bfhi(x0.y) * w0[3];
                    y[4] += bflo(x0.z) * w1[0]; y[5] += bfhi(x0.z) * w1[1]; y[6] += bflo(x0.w) * w1[2]; y[7] += bfhi(x0.w) * w1[3];
                    y[8] += bflo(x1.x) * w2[0]; y[9] += bfhi(x1.x) * w2[1]; y[10] += bflo(x1.y) * w2[2]; y[11] += bfhi(x1.y) * w2[3];
                    y[12] += bflo(x1.z) * w3[0]; y[13] += bfhi(x1.z) * w3[1]; y[14] += bflo(x1.w) * w3[2]; y[15] += bfhi(x1.w) * w3[3];
                }
            }
            float ss = 0.f;
#pragma unroll
            for (int q = 0; q < 16; ++q) { y[q] = siluf_(y[q]); ss += y[q] * y[q]; }
            if (which < 2) { ss += __shfl_xor(ss, 1); ss += __shfl_xor(ss, 2); ss += __shfl_xor(ss, 4); }
            if (which == 0) {
                const float sc = rsqrtf(ss + EPS) * 0.08838834764831845f;
                u32x4 a, d2, qa, qb2;
                a.x = pk2(y[0] * sc, y[1] * sc); a.y = pk2(y[2] * sc, y[3] * sc); a.z = pk2(y[4] * sc, y[5] * sc); a.w = pk2(y[6] * sc, y[7] * sc);
                d2.x = pk2(y[8] * sc, y[9] * sc); d2.y = pk2(y[10] * sc, y[11] * sc); d2.z = pk2(y[12] * sc, y[13] * sc); d2.w = pk2(y[14] * sc, y[15] * sc);
                *(LAS u32x4*)(Qs + t * 272 + ch0 * 2) = a; *(LAS u32x4*)(Qs + t * 272 + ch0 * 2 + 16) = d2;
                const float s2 = sc * eG;
                qa.x = pk2(y[0] * s2, y[1] * s2); qa.y = pk2(y[2] * s2, y[3] * s2); qa.z = pk2(y[4] * s2, y[5] * s2); qa.w = pk2(y[6] * s2, y[7] * s2);
                qb2.x = pk2(y[8] * s2, y[9] * s2); qb2.y = pk2(y[10] * s2, y[11] * s2); qb2.z = pk2(y[12] * s2, y[13] * s2); qb2.w = pk2(y[14] * s2, y[15] * s2);
                *(u32x4*)(QD + t * 128 + ch0) = qa; *(u32x4*)(QD + t * 128 + ch0 + 8) = qb2;
            } else if (which == 1) {
                const float sc = rsqrtf(ss + EPS);
                u32x4 a, d2;
                a.x = pk2(y[0] * sc, y[1] * sc); a.y = pk2(y[2] * sc, y[3] * sc); a.z = pk2(y[4] * sc, y[5] * sc); a.w = pk2(y[6] * sc, y[7] * sc);
                d2.x = pk2(y[8] * sc, y[9] * sc); d2.y = pk2(y[10] * sc, y[11] * sc); d2.z = pk2(y[12] * sc, y[13] * sc); d2.w = pk2(y[14] * sc, y[15] * sc);
                *(LAS u32x4*)(Ks + t * 272 + ch0 * 2) = a; *(LAS u32x4*)(Ks + t * 272 + ch0 * 2 + 16) = d2;
                const float s1 = sc * bt * eG, s3 = sc * eGl;
#pragma unroll
                for (int q = 0; q < 16; ++q) {
                    *(LAS bf16_t*)(KtW + (ch0 + q) * 144 + t * 2) = (bf16_t)f2bf(y[q] * s1);
                    *(LAS bf16_t*)(KdT + (ch0 + q) * 144 + t * 2) = (bf16_t)f2bf(y[q] * s3);
                }
            } else {
#pragma unroll
                for (int q = 0; q < 16; ++q) *(LAS bf16_t*)(Vt + (ch0 + q) * 144 + t * 2) = (bf16_t)f2bf(y[q] * bt);
            }
        }
    }
    __syncthreads();
    {
        const int itile = w & 3; const bool isq = w >= 4;
        LAS unsigned char* Arows = isq ? Qs : Ks;
        bf16x8 af[4];
#pragma unroll
        for (int k4 = 0; k4 < 4; ++k4) af[k4] = *(const LAS bf16x8*)(Arows + (itile * 16 + fr) * 272 + (k4 * 32 + fq * 8) * 2);
#pragma unroll
        for (int jt = 0; jt < 4; ++jt) {
            f32x4 acc = (f32x4){0.f, 0.f, 0.f, 0.f};
#pragma unroll
            for (int k4 = 0; k4 < 4; ++k4) {
                const bf16x8 bfv = *(const LAS bf16x8*)(Ks + (jt * 16 + fr) * 272 + (k4 * 32 + fq * 8) * 2);
                acc = __builtin_amdgcn_mfma_f32_16x16x32_bf16(af[k4], bfv, acc, 0, 0, 0);
            }
            const int j = jt * 16 + fr; const float Gj = sG[j];
#pragma unroll
            for (int jj = 0; jj < 4; ++jj) {
                const int i = itile * 16 + fq * 4 + jj;
                const float dec = __expf(sG[i] - Gj);
                if (!isq) A2[i * 64 + (j & 7) * 8 + (j >> 3)] = (j < i) ? sB[i] * acc[jj] * dec : 0.f;
                else *(LAS bf16_t*)(Qs + i * 272 + j * 2) = (bf16_t)f2bf((j <= i) ? acc[jj] * dec : 0.f);
            }
        }
    }
    __syncthreads();
    { const int r = tid >> 3, ch = tid & 7; *(u32x4*)(QK + r * 64 + ch * 8) = *(const LAS u32x4*)(Qs + r * 272 + ch * 16); }
    for (int r2_ = 0; r2_ < 1 + ((SUBREP >> 9) & 1); ++r2_)
    {
        const int c = w * 8 + (lane >> 3), jg = lane & 7;
        float tt[8];
#pragma unroll
        for (int q = 0; q < 8; ++q) tt[q] = 0.f;
        f32x4 na0 = *(const LAS f32x4*)(A2 + jg * 8), na1 = *(const LAS f32x4*)(A2 + jg * 8 + 4);
#pragma unroll 1
        for (int i = 0; i < 64; ++i) {
            const f32x4 a0 = na0, a1 = na1;
            { const int i2 = (i + 1) & 63; na0 = *(const LAS f32x4*)(A2 + i2 * 64 + jg * 8); na1 = *(const LAS f32x4*)(A2 + i2 * 64 + jg * 8 + 4); }
            float part = (a0[0] * tt[0] + a0[1] * tt[1]) + (a0[2] * tt[2] + a0[3] * tt[3]) + ((a1[0] * tt[4] + a1[1] * tt[5]) + (a1[2] * tt[6] + a1[3] * tt[7]));
            part += __builtin_bit_cast(float, __builtin_amdgcn_update_dpp(0, __builtin_bit_cast(int, part), 0xB1, 0xF, 0xF, true));
            part += __builtin_bit_cast(float, __builtin_amdgcn_update_dpp(0, __builtin_bit_cast(int, part), 0x4E, 0xF, 0xF, true));
            part += __builtin_bit_cast(float, __builtin_amdgcn_update_dpp(0, __builtin_bit_cast(int, part), 0x141, 0xF, 0xF, true));
            const float tv = ((i == c) ? 1.0f : 0.0f) - part;
            const bool mine = jg == (i & 7); const int qi = i >> 3;
#pragma unroll
            for (int q = 0; q < 8; ++q) tt[q] = (mine && q == qi) ? tv : tt[q];
        }
#pragma unroll
        for (int q = 0; q < 8; ++q) *(LAS bf16_t*)(Ts + (jg + 8 * q) * 144 + c * 2) = (bf16_t)f2bf(tt[q]);
    }
    __syncthreads();
    {
        bf16x8 va[2], ka[2];
#pragma unroll
        for (int k2 = 0; k2 < 2; ++k2) {
            va[k2] = *(const LAS bf16x8*)(Vt + (w * 16 + fr) * 144 + (k2 * 32 + fq * 8) * 2);
            ka[k2] = *(const LAS bf16x8*)(KtW + (w * 16 + fr) * 144 + (k2 * 32 + fq * 8) * 2);
        }
#pragma unroll
        for (int jt = 0; jt < 4; ++jt) {
            f32x4 au = (f32x4){0.f, 0.f, 0.f, 0.f}, aw = (f32x4){0.f, 0.f, 0.f, 0.f};
#pragma unroll
            for (int k2 = 0; k2 < 2; ++k2) {
                const bf16x8 tf = *(const LAS bf16x8*)(Ts + (jt * 16 + fr) * 144 + (k2 * 32 + fq * 8) * 2);
                au = __builtin_amdgcn_mfma_f32_16x16x32_bf16(va[k2], tf, au, 0, 0, 0);
                aw = __builtin_amdgcn_mfma_f32_16x16x32_bf16(tf, ka[k2], aw, 0, 0, 0);
            }
            *(f32x4*)(UT + ((size_t)(w * 4 + jt) * 64 + lane) * 4) = au;
#pragma unroll
            for (int jj = 0; jj < 4; ++jj) *(LAS bf16_t*)(Ks + (jt * 16 + fq * 4 + jj) * 272 + (w * 16 + fr) * 2) = (bf16_t)f2bf(-aw[jj]);
        }
#pragma unroll
        for (int pp = 0; pp < 2; ++pp) {
            const int id = tid + pp * 512, r = id >> 3, ch = id & 7;
            *(u32x4*)(KDT + r * 64 + ch * 8) = *(const LAS u32x4*)(KdT + r * 144 + ch * 16);
        }
    }
    __syncthreads();
#pragma unroll
    for (int pp = 0; pp < 2; ++pp) { const int id = tid + pp * 512, r = id >> 4, ch = id & 15; *(u32x4*)(WN + r * 128 + ch * 8) = *(const LAS u32x4*)(Ks + r * 272 + ch * 16); }
    __syncthreads();
}

struct ScanFrags { bf16x8 wn[4]; bf16x8 qd[4]; bf16x8 qk[2]; bf16x8 kd[1][2]; f32x4 ut; float gl; };
__device__ __forceinline__ void scan_load(ScanFrags& f, PK p, int unit, int s, int w, int lane) {
    const int fr = lane & 15, fq = lane >> 4, et = w >> 2, xt = w & 3;
    const unsigned char* ws = p->ws;
    const bf16_t* WN = (const bf16_t*)(ws + WS_WN) + (size_t)unit * 8192;
    const bf16_t* QD = (const bf16_t*)(ws + WS_QD) + (size_t)unit * 8192;
    const bf16_t* KDT = (const bf16_t*)(ws + WS_KDT) + (size_t)unit * 8192;
    const bf16_t* QK = (const bf16_t*)(ws + WS_QK) + (size_t)unit * 4096;
    const float* UT = (const float*)(ws + WS_UT) + (size_t)unit * 8192;
#pragma unroll
    for (int k4 = 0; k4 < 4; ++k4) { f.wn[k4] = *(const bf16x8*)(WN + (xt * 16 + fr) * 128 + k4 * 32 + fq * 8); f.qd[k4] = *(const bf16x8*)(QD + (xt * 16 + fr) * 128 + k4 * 32 + fq * 8); }
#pragma unroll
    for (int k2 = 0; k2 < 2; ++k2) { f.qk[k2] = *(const bf16x8*)(QK + (xt * 16 + fr) * 64 + k2 * 32 + fq * 8); f.kd[0][k2] = *(const bf16x8*)(KDT + (w * 16 + fr) * 64 + k2 * 32 + fq * 8); }
    f.ut = *(const f32x4*)(UT + ((size_t)((s * 2 + et) * 4 + xt) * 64 + lane) * 4);
    { int z_ = 0; asm volatile("" : "+v"(z_)); f.gl = ((const float*)(ws + WS_GL))[unit + z_]; }
}
#define LBAR() do { asm volatile("s_waitcnt lgkmcnt(0)" ::: "memory"); __builtin_amdgcn_s_barrier(); asm volatile("" ::: "memory"); } while (0)
struct ScanState { f32x4 sacc[2]; };
__device__ __forceinline__ void scan_step(const ScanFrags& cur, ScanState& S, LAS unsigned char* St, LAS unsigned char* uT, float* ODF, int b, int h, int s, int n, int w, int lane) {
    const int fr = lane & 15, fq = lane >> 4, et = w >> 2, xt = w & 3;
    bf16x8 sa[4];
#pragma unroll
    for (int k4 = 0; k4 < 4; ++k4) sa[k4] = *(const LAS bf16x8*)(St + (et * 16 + fr) * 272 + (k4 * 32 + fq * 8) * 2);
    f32x4 u = cur.ut;
#pragma unroll
    for (int k4 = 0; k4 < 4; ++k4) u = __builtin_amdgcn_mfma_f32_16x16x32_bf16(sa[k4], cur.wn[k4], u, 0, 0, 0);
#pragma unroll
    for (int jj = 0; jj < 4; ++jj) *(LAS bf16_t*)(uT + (et * 16 + fq * 4 + jj) * 144 + (xt * 16 + fr) * 2) = (bf16_t)f2bf(u[jj]);
    f32x4 o = (f32x4){0.f, 0.f, 0.f, 0.f};
#pragma unroll
    for (int k4 = 0; k4 < 4; ++k4) o = __builtin_amdgcn_mfma_f32_16x16x32_bf16(sa[k4], cur.qd[k4], o, 0, 0, 0);
    LBAR();
    bf16x8 ua[2];
#pragma unroll
    for (int k2 = 0; k2 < 2; ++k2) ua[k2] = *(const LAS bf16x8*)(uT + (et * 16 + fr) * 144 + (k2 * 32 + fq * 8) * 2);
#pragma unroll
    for (int k2 = 0; k2 < 2; ++k2) o = __builtin_amdgcn_mfma_f32_16x16x32_bf16(ua[k2], cur.qk[k2], o, 0, 0, 0);
    *(f32x4*)(ODF + (size_t)(b * 2048 + n * 64 + xt * 16 + fr) * 512 + h * 128 + s * 32 + et * 16 + fq * 4) = o;
#pragma unroll
    for (int e2 = 0; e2 < 2; ++e2) {
        bf16x8 ue[2];
#pragma unroll
        for (int k2 = 0; k2 < 2; ++k2) ue[k2] = *(const LAS bf16x8*)(uT + (e2 * 16 + fr) * 144 + (k2 * 32 + fq * 8) * 2);
        f32x4 a = S.sacc[e2] * cur.gl;
#pragma unroll
        for (int k2 = 0; k2 < 2; ++k2) a = __builtin_amdgcn_mfma_f32_16x16x32_bf16(ue[k2], cur.kd[0][k2], a, 0, 0, 0);
        S.sacc[e2] = a;
    }
    LBAR();
#pragma unroll
    for (int e2 = 0; e2 < 2; ++e2)
#pragma unroll
        for (int jj = 0; jj < 4; ++jj) *(LAS bf16_t*)(St + (e2 * 16 + fq * 4 + jj) * 272 + (w * 16 + fr) * 2) = (bf16_t)f2bf(S.sacc[e2][jj]);
    LBAR();
}
__device__ __forceinline__ void dn_scan(const Ctx& C, int l, PK p) {
    if (C.bid >= 128) return;
    const int q_ = C.bid >> 3, s = q_ & 3, chain = (C.bid & 7) + 8 * (q_ >> 2), b = chain >> 2, h = chain & 3;
    const int w = C.wave, lane = C.lane, fr = lane & 15, fq = lane >> 4;
    LAS unsigned char* St = C.lds;
    LAS unsigned char* uT = C.lds + 8704;
    float* ODF = (float*)(p->ws + WS_ODF);
    ScanState S;
    S.sacc[0] = (f32x4){0.f, 0.f, 0.f, 0.f}; S.sacc[1] = (f32x4){0.f, 0.f, 0.f, 0.f};
    for (int i = C.tid; i < 8704 / 4; i += 512) ((LAS unsigned*)St)[i] = 0u;
    ScanFrags fa, fb, fc;
    const int u0 = (b * 32) * 4 + h;
    scan_load(fa, p, u0, s, w, lane);
    scan_load(fb, p, u0 + 4, s, w, lane);
    __syncthreads();
#pragma unroll 1
    for (int n = 0; n < 33; n += 3) {
        if (n + 2 < 32) scan_load(fc, p, u0 + (n + 2) * 4, s, w, lane);
        scan_step(fa, S, St, uT, ODF, b, h, s, n, w, lane);
        if (n + 3 < 32) scan_load(fa, p, u0 + (n + 3) * 4, s, w, lane);
        scan_step(fb, S, St, uT, ODF, b, h, s, n + 1, w, lane);
        if (n + 2 >= 32) break;
        if (n + 4 < 32) scan_load(fb, p, u0 + (n + 4) * 4, s, w, lane);
        scan_step(fc, S, St, uT, ODF, b, h, s, n + 2, w, lane);
    }
    float* So = p->out + O_DNP + ((size_t)(l * 8 + b) * 4 + h) * 16384;
#pragma unroll
    for (int e2 = 0; e2 < 2; ++e2)
#pragma unroll
        for (int jj = 0; jj < 4; ++jj) So[(size_t)(w * 16 + fr) * 128 + s * 32 + e2 * 16 + fq * 4 + jj] = S.sacc[e2][jj];
}

__device__ __forceinline__ void sample_merge(const Ctx& C, const bf16_t* wa, const bf16_t* wd, const bf16_t* OA, const bf16_t* OD, const bf16_t* P, bf16_t* MRG) {
    const int ct = C.bid, rt = C.wave, fr = C.lane & 15, fq = C.lane >> 4;
    const int lc = ct * 16 + fr, lg = lc & 31;
    const int phys = (lc & ~31) + ((lg >> 2) & 1) * 16 + (lg >> 3) * 4 + (lg & 3);
    const bf16_t* war = wa + (size_t)phys * 1024 + fq * 8; const bf16_t* wdr = wa + (size_t)phys * 1024 + 512 + fq * 8; (void)wd;
    const size_t trow = (size_t)TP + rt * 16 + fr;
    const bf16_t* xar = OA + trow * 1024 + fq * 8; const bf16_t* xdr = OA + trow * 1024 + 512 + fq * 8; (void)OD;
    f32x4 aa = (f32x4){0.f, 0.f, 0.f, 0.f}, ad = (f32x4){0.f, 0.f, 0.f, 0.f};
#pragma unroll 4
    for (int k = 0; k < 16; ++k) {
        const bf16x8 wfa = *(const bf16x8*)(war + k * 32), wfd = *(const bf16x8*)(wdr + k * 32);
        const bf16x8 xa = *(const bf16x8*)(xar + k * 32), xd = *(const bf16x8*)(xdr + k * 32);
        aa = __builtin_amdgcn_mfma_f32_16x16x32_bf16(wfa, xa, aa, 0, 0, 0);
        ad = __builtin_amdgcn_mfma_f32_16x16x32_bf16(wfd, xd, ad, 0, 0, 0);
    }
    const int col0 = ct * 16 + fq * 4;
    const u32x2 ga = *(const u32x2*)(P + trow * NIN + PC_GA + col0), gd = *(const u32x2*)(P + trow * NIN + PC_GD + col0);
    u32x2 w;
    w.x = pk2(sigmoidf_(bflo(ga.x)) * aa[0] + sigmoidf_(bflo(gd.x)) * ad[0], sigmoidf_(bfhi(ga.x)) * aa[1] + sigmoidf_(bfhi(gd.x)) * ad[1]);
    w.y = pk2(sigmoidf_(bflo(ga.y)) * aa[2] + sigmoidf_(bflo(gd.y)) * ad[2], sigmoidf_(bfhi(ga.y)) * aa[3] + sigmoidf_(bfhi(gd.y)) * ad[3]);
    *(u32x2*)(MRG + trow * DM + col0) = w;
}

#define XB_TMO      128
#define XB_XCNT(j)  (256  + 64 * (j))
#define XB_XSUB(j)  (1280 + 64 * (j))
#define XB_XGEN(j)  (2304 + 64 * (j))
#define XB_TOP      3328
#define XB_TOPGEN   3392
#define XCD_BAR_WORDS 3456
#define XB_SPIN_CAP (1u << 20)
__device__ __forceinline__ unsigned xb_ld(unsigned* p)              { return __hip_atomic_load(p, __ATOMIC_RELAXED, __HIP_MEMORY_SCOPE_AGENT); }
__device__ __forceinline__ unsigned xb_add(unsigned* p, unsigned v) { return __hip_atomic_fetch_add(p, v, __ATOMIC_RELAXED, __HIP_MEMORY_SCOPE_AGENT); }
__device__ __forceinline__ unsigned xb_xcc_id() { return (unsigned)__builtin_amdgcn_s_getreg((3 << 11) | 20) & 0xFu; }
#define XB_SPIN(cond, bar) do { unsigned _sp = 0; while (cond) { __builtin_amdgcn_s_sleep(1); \
    if ((++_sp & 255u) == 0u) { if (xb_ld(&(bar)[XB_TMO])) break; if (_sp > XB_SPIN_CAP) { atomicAdd(&(bar)[XB_TMO], 1u); break; } } } } while (0)
struct XcdBarrier { unsigned* bar; unsigned x; volatile LAS unsigned* st; };
__device__ __forceinline__ XcdBarrier xcd_barrier_post(unsigned* bar, volatile LAS unsigned* st) {
    XcdBarrier b; b.bar = bar; b.x = xb_xcc_id(); b.st = st;
    if (threadIdx.x == 0) (void)xb_add(&bar[XB_XCNT(b.x)], 1u);
    return b;
}
__device__ __forceinline__ void xcd_barrier_complete(unsigned* bar, unsigned x, unsigned& nloc, unsigned& nx) {
    const unsigned G = gridDim.x * gridDim.y * gridDim.z;
    unsigned sum, cnt, mine, sp = 0u;
    for (;;) {
        sum = 0u; cnt = 0u; mine = 0u;
#pragma unroll
        for (unsigned j = 0; j < 16; ++j) { const unsigned c = xb_ld(&bar[XB_XCNT(j)]); sum += c; cnt += (c > 0u) ? 1u : 0u; mine = (j == x) ? c : mine; }
        if (sum == G) break;
        __builtin_amdgcn_s_sleep(1);
        if ((++sp & 255u) == 0u) { if (xb_ld(&bar[XB_TMO])) break; if (sp > XB_SPIN_CAP) { atomicAdd(&bar[XB_TMO], 1u); break; } }
    }
    nloc = mine > 0u ? mine : 1u; nx = cnt > 0u ? cnt : 1u;
}
__device__ __forceinline__ void xcd_barrier(const XcdBarrier& b) {
    asm volatile("s_waitcnt vmcnt(0)" ::: "memory");
    __syncthreads();
    if (threadIdx.x == 0) {
        unsigned* bar = b.bar;
        __builtin_amdgcn_s_waitcnt(0);
        unsigned nloc = b.st[0], nx = b.st[1];
        if (nloc == 0u) { xcd_barrier_complete(bar, b.x, nloc, nx); b.st[0] = nloc; b.st[1] = nx; }
        const unsigned old = xb_add(&bar[XB_XSUB(b.x)], 1u);
        const unsigned gen = old / nloc;
        if (old + 1u == (gen + 1u) * nloc) {
            __builtin_amdgcn_fence(__ATOMIC_RELEASE, "agent");
            asm volatile("s_waitcnt vmcnt(0)" ::: "memory");
            const unsigned og = xb_add(&bar[XB_TOP], 1u);
            const unsigned tg = og / nx;
            if (og + 1u == (tg + 1u) * nx) xb_add(&bar[XB_TOPGEN], 1u);
            else XB_SPIN(xb_ld(&bar[XB_TOPGEN]) == tg, bar);
            __builtin_amdgcn_fence(__ATOMIC_ACQUIRE, "agent");
            xb_add(&bar[XB_XGEN(b.x)], 1u);
            asm volatile("s_waitcnt vmcnt(0)" ::: "memory");
        } else {
            XB_SPIN(xb_ld(&bar[XB_XGEN(b.x)]) == gen, bar);
            __builtin_amdgcn_fence(__ATOMIC_ACQUIRE, "agent");
            asm volatile("s_waitcnt vmcnt(0)" ::: "memory");
        }
    }
    __syncthreads();
}

#ifndef DISMASK
#define DISMASK 0
#endif
#define EN(x) (((DISMASK >> (x)) & 1) == 0)
#ifndef REPMASK
#define REPMASK 0
#endif
constexpr int NPH = 2 + 13 * DEPTH;
__global__ void __launch_bounds__(512, 2) fwd_megakernel(Params p_unused, int ph_lo, int ph_hi) {
    extern __shared__ __attribute__((aligned(16))) unsigned char lds_raw[];
    cg::grid_group grid = cg::this_grid();
    volatile LAS unsigned* MISC = (volatile LAS unsigned*)((LAS unsigned char*)lds_raw + LDS_BYTES - 64);
    if (threadIdx.x < 16) MISC[threadIdx.x] = 0u;
    __syncthreads();
    const XcdBarrier xbar = xcd_barrier_post((unsigned*)(((PK)__builtin_amdgcn_kernarg_segment_ptr())->ws + WS_BAR), MISC);
#pragma unroll 1
    for (int ph = ph_lo, rep = 0; ph < ph_hi;) {
        const __attribute__((address_space(4))) unsigned char* kp_ = (const __attribute__((address_space(4))) unsigned char*)__builtin_amdgcn_kernarg_segment_ptr();
        asm volatile("" : "+s"(kp_));
        PK p = (PK)kp_;
        unsigned char* ws = p->ws;
        int tid_ = threadIdx.x;
        asm volatile("" : "+v"(tid_));
        Ctx C; C.lds = (LAS unsigned char*)lds_raw; C.tid = tid_; C.lane = C.tid & 63; C.wave = __builtin_amdgcn_readfirstlane(C.tid >> 6); { int g_ = gridDim.x, b_ = blockIdx.x; asm volatile("" : "+s"(g_), "+s"(b_)); C.G = g_; C.bid = b_; }
        bf16_t* WB = (bf16_t*)(ws + WS_W);
        float* H = (float*)(ws + WS_H);
        bf16_t* XN = (bf16_t*)(ws + WS_XN);
        bf16_t* ACT = (bf16_t*)(ws + WS_ACT);
        float* TMP = (float*)(ws + WS_ACT);
        bf16_t* P = (bf16_t*)(ws + WS_P);
        bf16_t* OA = (bf16_t*)(ws + WS_OA);
        bf16_t* OD = (bf16_t*)(ws + WS_OA);
        float* BG = (float*)(ws + WS_BG);
        float2* ROPE = (float2*)(ws + WS_ROPE);
        float* YP = p->out + O_YP; float* YS = p->out + O_YS;
        if (ph == 0 && EN(13)) {
#pragma unroll 1
            for (int l = 0; l < DEPTH; ++l) {
                bf16_t* wl = WB + (size_t)l * WL_END;
                convert_weight(C, p->ffn1_gu + (size_t)l * DM * 5632, 5632, DM, 5632, 1, wl + WL_GU1);
                convert_weight(C, p->ffn1_dn + (size_t)l * FF * DM, DM, FF, DM, 0, wl + WL_DN1);
                convert_weight(C, p->w_in + (size_t)l * DM * NINSRC, NINSRC, DM, NIN, 2, wl + WL_WIN);
                convert_weight(C, p->w_attn_o + (size_t)l * 512 * DM, DM, 512, DM, 0, wl + WL_AO, 1024, 0);
                convert_weight(C, p->w_dn_o + (size_t)l * 512 * DM, DM, 512, DM, 0, wl + WL_AO, 1024, 512);
                convert_weight(C, p->w_out + (size_t)l * DM * DM, DM, DM, DM, 0, wl + WL_WO);
                convert_weight(C, p->ffn2_gu + (size_t)l * DM * 5632, 5632, DM, 5632, 1, wl + WL_GU2);
                convert_weight(C, p->ffn2_dn + (size_t)l * FF * DM, DM, FF, DM, 0, wl + WL_DN2);
            }
            for (int i = C.bid * 512 + C.tid; i < 2049 * 32; i += C.G * 512) {
                const int pi = i >> 5, fi = i & 31;
                const float inv = 1.0f / exp2f((float)fi * (13.287712379549449f / 32.0f));
                const float posf = pi < 2048 ? (float)pi : 8192.0f;
                const float angf = posf * inv;
                const double ang = (double)angf;
                const double r = ang - 6.283185307179586 * rint(ang * 0.15915494309189535);
                const float rf = (float)r;
                ROPE[i] = make_float2(__cosf(rf), __sinf(rf));
            }
        } else if (ph == NPH - 1) {
            const float* PART = (const float*)(ws + WS_PART); const float* HS = H + (size_t)TP * DM;
            for (int r = C.bid * 8 + C.wave; r < TS; r += C.G * 8) {
#pragma unroll
                for (int c = 0; c < 4; ++c) {
                    f32x4 a = (f32x4){0.f, 0.f, 0.f, 0.f};
                    for (int i = 0; i < 11; ++i) a += *(const f32x4*)(PART + ((size_t)i * TS + r) * DM + c * 256 + C.lane * 4);
                    *(f32x4*)(YS + (size_t)r * DM + c * 256 + C.lane * 4) = *(const f32x4*)(HS + (size_t)r * DM + c * 256 + C.lane * 4) + 0.5f * a;
                }
            }
        } else {
            const int l = (ph - 1) / 13, k = (ph - 1) % 13;
            const bf16_t* wl = WB + (size_t)l * WL_END;
            const float* XinP = l == 0 ? p->x_prompt : YP; const float* XinS = l == 0 ? p->x_sample : YS;
            float* HS = H + (size_t)TP * DM;
            float* PART = (float*)(ws + WS_PART);
            if (k == 0 && EN(0)) {
                norm_phase<false>(C, XinP, l == 0 ? XinS : HS, p->ffn1_norm + l * DM, XN, nullptr, nullptr, PART, l == 0 ? 0 : 11, 0.5f, YS);
            } else if ((k == 1 || k == 11) && EN(1)) {
                pg8::Gemm g{XN, wl + (k == 1 ? WL_GU1 : WL_GU2), MP, 5632, DM}; pg8::StaticOrder S; S.init(5632, DM, C.G, C.bid, 128, 22, 16); EpiSwiglu E{ACT}; pg8::gemm_phase(C.lds, g, S, E, C.tid);
            } else if ((k == 2 || k == 12 || k == 9) && EN(2)) {
                pg8::Gemm g{k == 9 ? XN : ACT, wl + (k == 2 ? WL_DN1 : (k == 12 ? WL_DN2 : WL_WO)), MP, DM, k == 9 ? DM : FF}; pg8::StaticOrder S; S.init(DM, k == 9 ? DM : FF, C.G, C.bid, 0, k == 9 ? 16 : 44, 4);
                EpiResid E{k == 2 ? XinP : H, k == 12 ? YP : H, k == 9 ? 1.0f : 0.5f, PART};
                pg8::gemm_phase(C.lds, g, S, E, C.tid);
            } else if (k == 3 && EN(3)) {
                norm_phase<true>(C, H, XinS, p->mix_norm + l * DM, XN, p->w_in + (size_t)l * DM * NINSRC, BG, PART, 11, 0.5f, HS);
            } else if (k == 4 && EN(4)) {
                pg8::Gemm g{XN, wl + WL_WIN, MP, NIN, DM}; pg8::StaticOrder S; S.init(NIN, DM, C.G, C.bid, 192, 19, 16);
                EpiWin E{P, p->q_norm + l * 64, p->k_norm + l * 64, ROPE};
                pg8::gemm_phase(C.lds, g, S, E, C.tid);
            } else if (k == 5 && EN(5)) {
                for (int r_ = 0; r_ < 1 + ((SUBREP >> 1) & 1); ++r_)
                for (int u = C.bid; u < 1024; u += C.G) dn_pre_unit(C, u, l, p, P, BG);
                __syncthreads();
                for (int r_ = 0; r_ < 1 + ((SUBREP >> 3) & 1); ++r_)
                for (int t = C.bid; t < 512; t += C.G) dn_sample_task(C, t, l, p, P, BG, OD);
                for (int i = C.bid * 512 + C.tid; i < 262144; i += C.G * 512) {
                    const int which = i >> 17, r = i & 131071, d = r & 63, kvh = (r >> 6) & 1, j = (r >> 7) & 127, b = r >> 14;
                    const size_t row = (size_t)b * 2048 + 1920 + j;
                    p->out[(which ? O_VP : O_KP) + (size_t)l * 131072 + r] = bf1(P[row * NIN + (which ? PC_V : PC_K) + kvh * 64 + d]);
                }
                for (int i = C.bid * 512 + C.tid; i < 36864; i += C.G * 512) {
                    const int c = i % 1536, j = (i / 1536) % 3, b = i / 4608;
                    const size_t row = (size_t)b * 2048 + 2045 + j;
                    p->out[O_CVP + (size_t)l * 36864 + i] = bf1(P[row * NIN + PC_RAW + c]);
                }
            } else if (k == 6 && EN(6)) {
                if (C.bid < 128 || C.G != 256) dn_scan(C, l, p);
                if (C.bid >= 128 || C.G != 256) {
                const int bid2 = C.G == 256 ? C.bid - 128 : C.bid, G2 = C.G == 256 ? 128 : C.G;
                for (int r_ = 0; r_ < 1 + ((SUBREP >> 0) & 1); ++r_)
                for (int u = bid2; u < 256; u += G2) attn_prompt_unit(C, u, P, p->sinks + l * 8, OA);
                for (int r_ = 0; r_ < 1 + ((SUBREP >> 2) & 1); ++r_)
                for (int t = bid2 * 8 + C.wave; t < 1024; t += G2 * 8) attn_sample_task(C, t, l, p, P, OA);
                }
            } else if (k == 7 && EN(7)) {
                if (C.bid < 64) sample_merge(C, wl + WL_AO, wl + WL_DO, OA, OD, P, XN);
                finalize_od(C, (const float*)(ws + WS_ODF), P, p->dn_out_norm + l * 128, OD);
            } else if (k == 8 && EN(8)) {
                pg8::Gemm g{OA, wl + WL_AO, MP, DM, 1024}; pg8::StaticOrder S; S.init(DM, 1024, C.G, C.bid, 0, 0, 16);
                EpiGateK E{P, XN};
                pg8::gemm_phase<EpiGateK, true>(C.lds, g, S, E, C.tid);
            } else if (k == 10 && EN(10)) {
                norm_phase<false>(C, H, HS, p->ffn2_norm + l * DM, XN, nullptr, nullptr, PART, 4, 1.0f, HS);
            }
        }
        { const int kk_ = ph == 0 ? 13 : (ph - 1) % 13;
          if (rep == 0 && ((REPMASK >> kk_) & 1)) { rep = 1; xcd_barrier(xbar); continue; } }
        rep = 0; ++ph;
        if (ph < ph_hi) { if (ph == 1) grid.sync(); else xcd_barrier(xbar); }
    }
}

extern "C" void kernel_launch(void* const* d_in, const int* in_sizes, int n_in, void* d_out, int out_size, void* d_ws, size_t ws_size, hipStream_t stream) {
    static int grid = 0;
    if (grid == 0) {
        if (n_in != 24 || ws_size < WS_END) { fprintf(stderr, "kernel_launch: unexpected n_in %d / ws_size %zu (need %zu)\n", n_in, ws_size, (size_t)WS_END); grid = -1; return; }
        int dev = 0, cus = 0, per_cu = 0;
        hipGetDevice(&dev);
        hipDeviceGetAttribute(&cus, hipDeviceAttributeMultiprocessorCount, dev);
        if (hipFuncSetAttribute((const void*)fwd_megakernel, hipFuncAttributeMaxDynamicSharedMemorySize, LDS_BYTES) != hipSuccess) { fprintf(stderr, "hipFuncSetAttribute failed\n"); grid = -1; return; }
        hipOccupancyMaxActiveBlocksPerMultiprocessor(&per_cu, (const void*)fwd_megakernel, 512, LDS_BYTES);
        (void)hipGetLastError();
        if (per_cu < 1) per_cu = 1;
        grid = cus;
    }
    if (grid < 0) return;
    if (hipMemsetAsync((char*)d_ws + WS_BAR, 0, 16384, stream) != hipSuccess) { fprintf(stderr, "memset failed\n"); return; }
    Params p{};
    const float* const* in = (const float* const*)d_in;
    p.x_prompt = in[0]; p.x_sample = in[1]; p.cache_k = in[2]; p.cache_v = in[3]; p.state_dn = in[4]; p.state_conv = in[5];
    p.ffn1_norm = in[6]; p.ffn1_gu = in[7]; p.ffn1_dn = in[8]; p.mix_norm = in[9]; p.w_in = in[10]; p.q_norm = in[11]; p.k_norm = in[12];
    p.sinks = in[13]; p.conv_w = in[14]; p.A_log = in[15]; p.dt_bias = in[16]; p.dn_out_norm = in[17]; p.w_attn_o = in[18]; p.w_dn_o = in[19];
    p.w_out = in[20]; p.ffn2_norm = in[21]; p.ffn2_gu = in[22]; p.ffn2_dn = in[23];
    p.out = (float*)d_out; p.ws = (unsigned char*)d_ws;
    int ph_lo = 0, ph_hi = NPH;
    void* args[] = {&p, &ph_lo, &ph_hi};
    hipError_t e = hipLaunchCooperativeKernel((const void*)fwd_megakernel, dim3(grid), dim3(512), args, LDS_BYTES, stream);
    if (e != hipSuccess) fprintf(stderr, "cooperative launch failed: %s (grid %d)\n", hipGetErrorString(e), grid);
}
```

```cpp
#include <hip/hip_runtime.h>
#include <hip/hip_cooperative_groups.h>
#include <cstdio>
#include <cstdint>
namespace cg = cooperative_groups;
#ifndef SUBREP
#define SUBREP 0
#endif

#define LAS __attribute__((address_space(3)))
typedef unsigned short bf16_t;
typedef short bf16x8 __attribute__((ext_vector_type(8)));
typedef float f32x4 __attribute__((ext_vector_type(4)));
typedef unsigned u32x4 __attribute__((ext_vector_type(4)));
typedef unsigned u32x2 __attribute__((ext_vector_type(2)));

constexpr int TP = 16384, TS = 128, TT = TP + TS, MP = 16640;
constexpr int DM = 1024, FF = 2816, NIN = 4864, NINSRC = 4872, DEPTH = 4;
constexpr float EPS = 1e-6f;
constexpr int PC_Q = 0, PC_K = 512, PC_V = 640, PC_RAW = 768, PC_Z = 2304, PC_GA = 2816, PC_GD = 3840;
constexpr size_t O_YP = 0, O_YS = 16777216, O_KP = 16908288, O_VP = 17432576, O_DNP = 17956864, O_CVP = 20054016,
                 O_KS = 20201472, O_VS = 28590080, O_DNS = 36978688, O_CVS = 70533120;
constexpr size_t WL_GU1 = 0, WL_DN1 = WL_GU1 + (size_t)5632 * 1024, WL_WIN = WL_DN1 + (size_t)1024 * 2816, WL_AO = WL_WIN + (size_t)NIN * 1024,
                 WL_DO = WL_AO + (size_t)1024 * 512, WL_WO = WL_DO + (size_t)1024 * 512, WL_GU2 = WL_WO + (size_t)1024 * 1024,
                 WL_DN2 = WL_GU2 + (size_t)5632 * 1024, WL_END = WL_DN2 + (size_t)1024 * 2816;
constexpr size_t MiB = 1u << 20;
constexpr size_t WS_ROPE = 0;
constexpr size_t WS_BG = 1 * MiB;
constexpr size_t WS_GL = 2 * MiB;
constexpr size_t WS_BAR = 2 * MiB + 65536;
constexpr size_t WS_W = 3 * MiB;
constexpr size_t WS_H = WS_W + ((WL_END * 2 * DEPTH + MiB - 1) / MiB) * MiB;
constexpr size_t WS_XN = WS_H + (size_t)MP * DM * 4;
constexpr size_t WS_ACT = WS_XN + (size_t)MP * DM * 2;
constexpr size_t WS_P = WS_ACT + (size_t)MP * FF * 2;
constexpr size_t WS_OA = WS_P + (size_t)MP * NIN * 2;
constexpr size_t WS_OD = WS_OA + (size_t)MP * 512 * 2;
constexpr size_t WS_ODF = WS_OD + (size_t)MP * 512 * 2;
constexpr size_t WS_PART = WS_ODF + (size_t)TP * 512 * 4;
constexpr size_t WS_END = WS_PART + (size_t)11 * TS * DM * 4;
constexpr size_t WS_UT = WS_ACT;
constexpr size_t WS_WN = WS_UT + (size_t)1024 * 8192 * 4;
constexpr size_t WS_QD = WS_WN + (size_t)1024 * 8192 * 2;
constexpr size_t WS_KDT = WS_QD + (size_t)1024 * 8192 * 2;
constexpr size_t WS_QK = WS_KDT + (size_t)1024 * 8192 * 2;
static_assert(WS_QK + (size_t)1024 * 4096 * 2 <= WS_P, "deltanet overlay fits in ACT");
static_assert((size_t)MP * DM * 4 <= (size_t)MP * FF * 2, "TMP fits in ACT");

constexpr int LDS_BYTES = 147456;

struct Params {
    const float* x_prompt; const float* x_sample; const float* cache_k; const float* cache_v; const float* state_dn; const float* state_conv;
    const float* ffn1_norm; const float* ffn1_gu; const float* ffn1_dn; const float* mix_norm; const float* w_in; const float* q_norm; const float* k_norm;
    const float* sinks; const float* conv_w; const float* A_log; const float* dt_bias; const float* dn_out_norm; const float* w_attn_o; const float* w_dn_o;
    const float* w_out; const float* ffn2_norm; const float* ffn2_gu; const float* ffn2_dn;
    float* out; unsigned char* ws;
};

__device__ __forceinline__ unsigned pk2(float lo, float hi);
__device__ __forceinline__ unsigned f2bf(float f) { return pk2(f, 0.f) & 0xffffu; }
typedef float f32x2_t __attribute__((ext_vector_type(2)));
typedef __bf16 bf16x2_t __attribute__((ext_vector_type(2)));
__device__ __forceinline__ unsigned pk2(float lo, float hi) { const f32x2_t v = {lo, hi}; const bf16x2_t b = __builtin_convertvector(v, bf16x2_t); return __builtin_bit_cast(unsigned, b); }
__device__ __forceinline__ float bflo(unsigned w) { return __uint_as_float(w << 16); }
__device__ __forceinline__ float bfhi(unsigned w) { return __uint_as_float(w & 0xffff0000u); }
__device__ __forceinline__ float bf1(bf16_t v) { return __uint_as_float(((unsigned)v) << 16); }
__device__ __forceinline__ float sigmoidf_(float x) { return __builtin_amdgcn_rcpf(1.0f + __expf(-x)); }
__device__ __forceinline__ float siluf_(float x) { return x * __builtin_amdgcn_rcpf(1.0f + __expf(-x)); }
__device__ __forceinline__ float softplusf_(float x) { return x > 20.f ? x : log1pf(__expf(x)); }

namespace pg8 {
constexpr int BM = 256, BK = 64, HALF = 128, HTB = HALF * BK * 2, NXCD = 8, WGM = 8;
__host__ __device__ __forceinline__ int lds_byte(int r, int c) { const int st = (r >> 4) * 2 + (c >> 5), rr = r & 15, cc = c & 31, ob = rr * 64 + cc * 2; return st * 1024 + (ob ^ (((ob >> 9) & 1) << 5)); }
__host__ __device__ __forceinline__ void stage_rc(int b, int& R, int& C) { const int st = b / 1024, sb = b % 1024, swz = sb ^ (((sb >> 9) & 1) << 5); R = (st >> 1) * 16 + swz / 64; C = (st & 1) * 32 + (swz % 64) / 2; }
struct Unit { int pm, pn, k0, nt; };
struct Gemm { const bf16_t* A; const bf16_t* Bt; int M, N, K; };
struct StaticOrder {
    int nM, nN, nwg, G, c, ntMain, extraBase, nExtra, extraNt;
    __device__ void init(int N, int K, int G_, int c_, int extraBase_, int nExtra_, int extraNt_) { nM = 64; nN = N / BM; nwg = nM * nN; G = G_; c = c_; ntMain = K / BK; extraBase = extraBase_; nExtra = nExtra_; extraNt = extraNt_; }
    __device__ bool next(int i, Unit& u) const {
        const long L = (long)i * G + c;
        if (L < nwg) {
            int wgid = (int)L; { const int q = nwg / NXCD, r = nwg % NXCD, xcd = wgid % NXCD, off = wgid / NXCD; wgid = (xcd < r ? xcd * (q + 1) : r * (q + 1) + (xcd - r) * q) + off; }
            const int nig = WGM * nN, gid = wgid / nig, fm = gid * WGM, gsz = (nM - fm) < WGM ? (nM - fm) : WGM;
            u.pm = fm + ((wgid % nig) % gsz); u.pn = (wgid % nig) / gsz; u.k0 = 0; u.nt = ntMain; return true;
        }
        const int nc = (nwg - c + G - 1) / G, j = c - extraBase;
        if (i == nc && j >= 0 && j < nExtra) { u.pm = 64; u.pn = j % nN; u.k0 = (j / nN) * extraNt; u.nt = extraNt; return true; }
        return false;
    }
};
template <class Epi, bool HOOK = false>
__device__ __forceinline__ void gemm_phase(LAS unsigned char* lds, const Gemm g, const StaticOrder& S, const Epi& E, const int tid) {
    const int wid = __builtin_amdgcn_readfirstlane(tid >> 6), lane = tid & 63, wr = wid >> 2, wc = wid & 3, fr = lane & 15, fq = lane >> 4;
    const int K = g.K;
    unsigned voffA[2];
#pragma unroll
    for (int i = 0; i < 2; ++i) { int R, C; stage_rc(tid * 16 + i * 8192, R, C); voffA[i] = (unsigned)(R * K + C) * 2u; }
    const size_t kstep = (size_t)(BK * 2);
    const size_t hstep = (size_t)HALF * K * 2;
    const size_t tstep = 2 * hstep;
    const unsigned ldsw = (unsigned)wid * 1024u;
    const int aoff = lds_byte(wr * 64 + fr, fq * 8), boff = lds_byte(wc * 32 + fr, fq * 8);
#define PG8_SA(b, h) (((b) * 2 + (h)) * HTB)
#define PG8_SB(b, h) ((4 + (b) * 2 + (h)) * HTB)
#define PG8_STAGE(bufoff, gbase) do { _Pragma("unroll") for (int _i = 0; _i < 2; ++_i) \
        __builtin_amdgcn_global_load_lds((const unsigned*)((const char*)(gbase) + voffA[_i]), (LAS unsigned*)(lds + (bufoff) + ldsw + _i * 8192), 16, 0, 0); } while (0)
#define PG8_LDA(dst, b, h) do { _Pragma("unroll") for (int m = 0; m < 4; ++m) _Pragma("unroll") for (int k = 0; k < 2; ++k) dst[m][k] = *(const LAS bf16x8*)(lds + PG8_SA(b, h) + aoff + m * 2048 + k * 1024); } while (0)
#define PG8_LDB(dst, b, h) do { _Pragma("unroll") for (int n = 0; n < 2; ++n) _Pragma("unroll") for (int k = 0; k < 2; ++k) dst[n][k] = *(const LAS bf16x8*)(lds + PG8_SB(b, h) + boff + n * 2048 + k * 1024); } while (0)
#define PG8_MMA(ai, bj, At, Bt) do { __builtin_amdgcn_s_setprio(1); _Pragma("unroll") for (int m = 0; m < 4; ++m) _Pragma("unroll") for (int n = 0; n < 2; ++n) _Pragma("unroll") for (int k = 0; k < 2; ++k) \
        acc[ai][bj][m][n] = __builtin_amdgcn_mfma_f32_16x16x32_bf16(Bt[n][k], At[m][k], acc[ai][bj][m][n], 0, 0, 0); __builtin_amdgcn_s_setprio(0); } while (0)
#define PG8_WAIT_V(n) asm volatile("s_waitcnt vmcnt(" #n ")" ::: "memory")
#define PG8_WAIT_L(n) asm volatile("s_waitcnt lgkmcnt(" #n ")" ::: "memory")
#define PG8_BAR __builtin_amdgcn_s_barrier()
#define PG8_SCHED __builtin_amdgcn_sched_barrier(0)
    Unit cur, nxt; int ui = 0;
    if (!S.next(0, cur)) return;
    f32x4 acc[2][2][4][2];
#pragma unroll
    for (int a = 0; a < 2; ++a)
#pragma unroll
        for (int b = 0; b < 2; ++b)
#pragma unroll
            for (int m = 0; m < 4; ++m)
#pragma unroll
                for (int n = 0; n < 2; ++n) acc[a][b][m][n] = (f32x4){0.f, 0.f, 0.f, 0.f};
    bf16x8 At[4][2], B0[2][2], B1[2][2];
    const char* cA = (const char*)g.A + (size_t)cur.pm * tstep + (size_t)cur.k0 * kstep; const char* cB = (const char*)g.Bt + (size_t)cur.pn * tstep + (size_t)cur.k0 * kstep;
    PG8_STAGE(PG8_SB(0, 0), cB); PG8_STAGE(PG8_SB(0, 1), cB + hstep); PG8_STAGE(PG8_SA(0, 0), cA); PG8_STAGE(PG8_SA(0, 1), cA + hstep);
    if (wr == 1) PG8_BAR;
    PG8_WAIT_V(2); PG8_BAR;
    PG8_STAGE(PG8_SB(1, 0), cB + kstep); PG8_STAGE(PG8_SA(1, 0), cA + kstep); PG8_STAGE(PG8_SB(1, 1), cB + hstep + kstep);
    PG8_WAIT_V(6); PG8_BAR;
    for (;;) {
        const bool has_next = S.next(ui + 1, nxt);
        const char* nA = has_next ? (const char*)g.A + (size_t)nxt.pm * tstep + (size_t)nxt.k0 * kstep : cA; const char* nB = has_next ? (const char*)g.Bt + (size_t)nxt.pn * tstep + (size_t)nxt.k0 * kstep : cB;
        const int nt = cur.nt;
        for (int t = 0; t < nt; t += 2) {
            const bool last = (t == nt - 2);
            if constexpr (HOOK) if (t == 8) { int fr2 = fr, fq2 = fq; asm volatile("" : "+v"(fr2), "+v"(fq2)); E.mid(acc, cur, wr, wc, fr2, fq2); }
            const char* a1 = cA + (size_t)(t + 1) * kstep;
            const char* a2 = last ? nA : cA + (size_t)(t + 2) * kstep; const char* b2 = last ? nB : cB + (size_t)(t + 2) * kstep;
            const char* a3 = a2 + kstep; const char* b3 = b2 + kstep;
            PG8_LDB(B0, 0, 0); PG8_LDB(B1, 0, 1); PG8_SCHED; PG8_LDA(At, 0, 0); PG8_STAGE(PG8_SA(1, 1), a1 + hstep);
            PG8_WAIT_V(8); PG8_WAIT_L(0); PG8_BAR; PG8_MMA(0, 0, At, B0); PG8_MMA(0, 1, At, B1); PG8_BAR; PG8_SCHED;
            PG8_LDA(At, 0, 1); PG8_STAGE(PG8_SB(0, 0), b2); PG8_STAGE(PG8_SB(0, 1), b2 + hstep); PG8_STAGE(PG8_SA(0, 0), a2);
            PG8_WAIT_V(8); PG8_WAIT_L(0); PG8_BAR; PG8_MMA(1, 0, At, B0); PG8_MMA(1, 1, At, B1); PG8_BAR; PG8_SCHED;
            PG8_LDB(B0, 1, 0); PG8_LDB(B1, 1, 1); PG8_SCHED; PG8_LDA(At, 1, 0); PG8_STAGE(PG8_SA(0, 1), a2 + hstep);
            PG8_WAIT_V(8); PG8_WAIT_L(0); PG8_BAR; PG8_MMA(0, 0, At, B0); PG8_MMA(0, 1, At, B1); PG8_BAR; PG8_SCHED;
            PG8_LDA(At, 1, 1); PG8_STAGE(PG8_SB(1, 0), b3); PG8_STAGE(PG8_SB(1, 1), b3 + hstep); PG8_STAGE(PG8_SA(1, 0), a3);
            PG8_WAIT_V(8); PG8_WAIT_L(0); PG8_BAR; PG8_MMA(1, 0, At, B0); PG8_MMA(1, 1, At, B1); PG8_BAR; PG8_SCHED;
        }
        if (wr == 0) PG8_BAR;
        { int fr2 = fr, fq2 = fq; asm volatile("" : "+v"(fr2), "+v"(fq2)); E(acc, cur, wr, wc, fr2, fq2); }
        if (!has_next) break;
#pragma unroll
        for (int a = 0; a < 2; ++a)
#pragma unroll
            for (int b = 0; b < 2; ++b)
#pragma unroll
                for (int m = 0; m < 4; ++m)
#pragma unroll
                    for (int n = 0; n < 2; ++n) acc[a][b][m][n] = (f32x4){0.f, 0.f, 0.f, 0.f};
        cur = nxt; cA = nA; cB = nB; ++ui;
        if (wr == 1) PG8_BAR;
    }
    PG8_WAIT_V(0);
    PG8_BAR;
#undef PG8_SA
#undef PG8_SB
#undef PG8_STAGE
#undef PG8_LDA
#undef PG8_LDB
#undef PG8_MMA
#undef PG8_WAIT_V
#undef PG8_WAIT_L
#undef PG8_BAR
#undef PG8_SCHED
}
}

typedef f32x4 AccT[2][2][4][2];

struct EpiSwiglu {
    bf16_t* act;
    __device__ __forceinline__ void operator()(const AccT& acc, const pg8::Unit& u, int wr, int wc, int fr, int fq) const {
#pragma unroll
        for (int ai = 0; ai < 2; ++ai)
#pragma unroll
            for (int m = 0; m < 4; ++m) {
                const int row = u.pm * 256 + ai * 128 + wr * 64 + m * 16 + fr;
                bf16_t* rp = act + (size_t)row * FF + u.pn * 128 + wc * 32 + fq * 8;
                const f32x4 g0 = acc[ai][0][m][0], u0 = acc[ai][1][m][0], g1 = acc[ai][0][m][1], u1 = acc[ai][1][m][1];
                u32x4 w; w.x = pk2(siluf_(g0[0]) * u0[0], siluf_(g0[1]) * u0[1]); w.y = pk2(siluf_(g0[2]) * u0[2], siluf_(g0[3]) * u0[3]);
                w.z = pk2(siluf_(g1[0]) * u1[0], siluf_(g1[1]) * u1[1]); w.w = pk2(siluf_(g1[2]) * u1[2], siluf_(g1[3]) * u1[3]);
                *(u32x4*)rp = w;
            }
    }
};
struct EpiResid {
    const float* baseP; float* outP; float scale; float* part;
    __device__ __forceinline__ void operator()(const AccT& acc, const pg8::Unit& u, int wr, int wc, int fr, int fq) const {
        if (u.pm == 64) {
            float* pp = part + (size_t)(u.k0 / u.nt) * (TS * DM);
#pragma unroll
            for (int m = 0; m < 4; ++m) {
                const int r = wr * 64 + m * 16 + fr;
#pragma unroll
                for (int bj = 0; bj < 2; ++bj)
#pragma unroll
                    for (int n = 0; n < 2; ++n) *(f32x4*)(pp + (size_t)r * DM + u.pn * 256 + bj * 128 + wc * 32 + fq * 8 + n * 4) = acc[0][bj][m][n];
            }
            return;
        }
#pragma unroll
        for (int ai = 0; ai < 2; ++ai)
#pragma unroll
            for (int m = 0; m < 4; ++m) {
                const int row = u.pm * 256 + ai * 128 + wr * 64 + m * 16 + fr;
                const float* b = baseP + (size_t)row * DM;
                float* o = outP + (size_t)row * DM;
#pragma unroll
                for (int bj = 0; bj < 2; ++bj)
#pragma unroll
                    for (int n = 0; n < 2; ++n) {
                        const int col = u.pn * 256 + bj * 128 + wc * 32 + fq * 8 + n * 4;
                        const f32x4 bv = *(const f32x4*)(b + col);
                        *(f32x4*)(o + col) = bv + scale * acc[ai][bj][m][n];
                    }
            }
    }
};
template <bool SECOND> struct EpiGate {
    const bf16_t* P; float* tmp; bf16_t* mrg;
    __device__ __forceinline__ void operator()(const AccT& acc, const pg8::Unit& u, int wr, int wc, int fr, int fq) const {
#pragma unroll
        for (int ai = 0; ai < 2; ++ai)
#pragma unroll
            for (int m = 0; m < 4; ++m) {
                const int row = u.pm * 256 + ai * 128 + wr * 64 + m * 16 + fr;
                if (row >= TT) continue;
#pragma unroll
                for (int bj = 0; bj < 2; ++bj)
#pragma unroll
                    for (int n = 0; n < 2; ++n) {
                        const int col = u.pn * 256 + bj * 128 + wc * 32 + fq * 8 + n * 4;
                        const u32x2 gw = *(const u32x2*)(P + (size_t)row * NIN + (SECOND ? PC_GD : PC_GA) + col);
                        const f32x4 a = acc[ai][bj][m][n];
                        f32x4 v; v[0] = sigmoidf_(bflo(gw.x)) * a[0]; v[1] = sigmoidf_(bfhi(gw.x)) * a[1]; v[2] = sigmoidf_(bflo(gw.y)) * a[2]; v[3] = sigmoidf_(bfhi(gw.y)) * a[3];
                        float* tp = tmp + (size_t)row * DM + col;
                        if (!SECOND) { *(f32x4*)tp = v; }
                        else { const f32x4 t = *(const f32x4*)tp; v = v + t; u32x2 w; w.x = pk2(v[0], v[1]); w.y = pk2(v[2], v[3]); *(u32x2*)(mrg + (size_t)row * DM + col) = w; }
                    }
            }
    }
};
struct EpiGateK {
    const bf16_t* P; bf16_t* mrg;
    __device__ __forceinline__ void mid(AccT& acc, const pg8::Unit& u, int wr, int wc, int fr, int fq) const {
#pragma unroll
        for (int ai = 0; ai < 2; ++ai)
#pragma unroll
            for (int m = 0; m < 4; ++m) {
                const int row = u.pm * 256 + ai * 128 + wr * 64 + m * 16 + fr;
                if (row >= TT) continue;
#pragma unroll
                for (int bj = 0; bj < 2; ++bj) {
                    const int col = u.pn * 256 + bj * 128 + wc * 32 + fq * 8;
                    const u32x4 ga = *(const u32x4*)(P + (size_t)row * NIN + PC_GA + col), gd = *(const u32x4*)(P + (size_t)row * NIN + PC_GD + col);
                    const unsigned gaw[4] = {ga.x, ga.y, ga.z, ga.w}, gdw[4] = {gd.x, gd.y, gd.z, gd.w};
#pragma unroll
                    for (int q = 0; q < 4; ++q) {
                        const float ea0 = __expf(-bflo(gaw[q])), ea1 = __expf(-bfhi(gaw[q]));
                        const float ed0 = __expf(fminf(-bflo(gdw[q]), 60.f)), ed1 = __expf(fminf(-bfhi(gdw[q]), 60.f));
                        const float r0 = (1.0f + ed0) * __builtin_amdgcn_rcpf(1.0f + ea0), r1 = (1.0f + ed1) * __builtin_amdgcn_rcpf(1.0f + ea1);
                        acc[ai][bj][m][q >> 1][(q & 1) * 2 + 0] *= r0; acc[ai][bj][m][q >> 1][(q & 1) * 2 + 1] *= r1;
                    }
                }
                __builtin_amdgcn_sched_barrier(0);
            }
    }
    __device__ __forceinline__ void operator()(const AccT& acc, const pg8::Unit& u, int wr, int wc, int fr, int fq) const {
#pragma unroll
        for (int ai = 0; ai < 2; ++ai)
#pragma unroll
            for (int m = 0; m < 4; ++m) {
                const int row = u.pm * 256 + ai * 128 + wr * 64 + m * 16 + fr;
                if (row >= TT) continue;
#pragma unroll
                for (int bj = 0; bj < 2; ++bj) {
                    const int col = u.pn * 256 + bj * 128 + wc * 32 + fq * 8;
                    const u32x4 gd = *(const u32x4*)(P + (size_t)row * NIN + PC_GD + col);
                    const unsigned gdw[4] = {gd.x, gd.y, gd.z, gd.w};
                    unsigned ow[4];
#pragma unroll
                    for (int q = 0; q < 4; ++q) {
                        const float s0 = __builtin_amdgcn_rcpf(1.0f + __expf(fminf(-bflo(gdw[q]), 60.f))), s1 = __builtin_amdgcn_rcpf(1.0f + __expf(fminf(-bfhi(gdw[q]), 60.f)));
                        ow[q] = pk2(acc[ai][bj][m][q >> 1][(q & 1) * 2 + 0] * s0, acc[ai][bj][m][q >> 1][(q & 1) * 2 + 1] * s1);
                    }
                    *(u32x4*)(mrg + (size_t)row * DM + col) = (u32x4){ow[0], ow[1], ow[2], ow[3]};
                }
            }
    }
};
struct EpiWin {
    bf16_t* P; const float* qnw; const float* knw; const float2* rope;
    __device__ __forceinline__ void operator()(const AccT& acc, const pg8::Unit& u, int wr, int wc, int fr, int fq) const {
        const int tile = u.pn;
        const bool headed = tile <= 1 || (tile == 2 && wc < 2), isq = tile <= 1;
        const float* nw = isq ? qnw : knw;
        const float sc = isq ? 0.125f : 1.0f;
#pragma unroll
        for (int ai = 0; ai < 2; ++ai)
#pragma unroll
            for (int m = 0; m < 4; ++m) {
                const int row = u.pm * 256 + ai * 128 + wr * 64 + m * 16 + fr;
                const bool valid = row < TT;
                bf16_t* prow = P + (size_t)row * NIN + tile * 256 + wc * 64;
                if (headed) {
                    float ss = 0.f;
#pragma unroll
                    for (int bj = 0; bj < 2; ++bj)
#pragma unroll
                        for (int n = 0; n < 2; ++n) { const f32x4 a = acc[ai][bj][m][n]; ss += a[0] * a[0] + a[1] * a[1] + a[2] * a[2] + a[3] * a[3]; }
                    ss += __shfl_xor(ss, 16); ss += __shfl_xor(ss, 32);
                    if (!valid) continue;
                    const float rs = rsqrtf(ss * (1.0f / 64.0f) + EPS);
                    const float2* rp = rope + (size_t)(row < TP ? (row & 2047) : 2048) * 32;
#pragma unroll
                    for (int n = 0; n < 2; ++n) {
                        const int i0 = fq * 8 + n * 4;
                        const f32x4 w1 = *(const f32x4*)(nw + i0), w2 = *(const f32x4*)(nw + 32 + i0);
                        f32x4 o1, o2;
#pragma unroll
                        for (int j = 0; j < 4; ++j) {
                            const float x1 = acc[ai][0][m][n][j] * rs * w1[j], x2 = acc[ai][1][m][n][j] * rs * w2[j];
                            const float2 cs = rp[i0 + j];
                            o1[j] = (x1 * cs.x - x2 * cs.y) * sc; o2[j] = (x2 * cs.x + x1 * cs.y) * sc;
                        }
                        u32x2 a, b; a.x = pk2(o1[0], o1[1]); a.y = pk2(o1[2], o1[3]); b.x = pk2(o2[0], o2[1]); b.y = pk2(o2[2], o2[3]);
                        *(u32x2*)(prow + i0) = a; *(u32x2*)(prow + 32 + i0) = b;
                    }
                } else {
                    if (!valid) continue;
#pragma unroll
                    for (int bj = 0; bj < 2; ++bj)
#pragma unroll
                        for (int n = 0; n < 2; ++n) {
                            const f32x4 a = acc[ai][bj][m][n];
                            u32x2 w; w.x = pk2(a[0], a[1]); w.y = pk2(a[2], a[3]);
                            *(u32x2*)(prow + bj * 32 + fq * 8 + n * 4) = w;
                        }
                }
            }
    }
};

typedef const __attribute__((address_space(4))) Params* PK;
struct Ctx { LAS unsigned char* lds; int tid, lane, wave, G, bid; };

__device__ __forceinline__ int src_col(int type, int n0) {
    if (type == 0) return n0;
    const int tile = n0 >> 8, p = n0 & 255;
    if (type == 1) return p < 128 ? tile * 128 + p : FF + tile * 128 + (p - 128);
    const int bj = p >> 7, wc = (p >> 5) & 3, c32 = p & 31; const int lg = tile * 256 + wc * 64 + bj * 32 + c32;
    return lg < PC_GA ? lg : lg + 8;
}
__device__ __forceinline__ void convert_weight(const Ctx& C, const float* src, int ld, int K, int N, int type, bf16_t* dst, int dld = 0, int koff = 0) {
    if (dld == 0) dld = K;
    LAS float* tile = (LAS float*)C.lds;
    const int nnt = N / 32, nitems = nnt * (K / 256);
    for (int it = C.bid; it < nitems; it += C.G) {
        const int ntile = it % nnt, kt = it / nnt, n0 = ntile * 32, k0 = kt * 256, s0 = src_col(type, n0);
        const int c4 = (C.tid & 7) * 4, kr = C.tid >> 3;
        f32x4 v[4];
#pragma unroll
        for (int p = 0; p < 4; ++p) v[p] = *(const f32x4*)(src + (size_t)(k0 + p * 64 + kr) * ld + s0 + c4);
#pragma unroll
        for (int p = 0; p < 4; ++p) { LAS float* tp = tile + (p * 64 + kr) * 33 + c4; tp[0] = v[p][0]; tp[1] = v[p][1]; tp[2] = v[p][2]; tp[3] = v[p][3]; }
        __syncthreads();
#pragma unroll
        for (int h2 = 0; h2 < 2; ++h2) {
            const int n = C.tid >> 4, ks = (C.tid & 15) * 8 + h2 * 128;
            const int ln = 8 * ((n >> 2) & 3) + 4 * (n >> 4) + (n & 3);
            u32x4 w;
            w.x = pk2(tile[(ks + 0) * 33 + ln], tile[(ks + 1) * 33 + ln]); w.y = pk2(tile[(ks + 2) * 33 + ln], tile[(ks + 3) * 33 + ln]);
            w.z = pk2(tile[(ks + 4) * 33 + ln], tile[(ks + 5) * 33 + ln]); w.w = pk2(tile[(ks + 6) * 33 + ln], tile[(ks + 7) * 33 + ln]);
            *(u32x4*)(dst + (size_t)(n0 + n) * dld + koff + k0 + ks) = w;
        }
        __syncthreads();
    }
}

__device__ __forceinline__ float wave_sum(float v) {
#pragma unroll
    for (int o = 1; o < 64; o <<= 1) v += __shfl_xor(v, o);
    return v;
}

template <bool WITH_BG>
__device__ __forceinline__ void norm_phase(const Ctx& C, const float* inP, const float* inS, const float* w, bf16_t* xn, const float* win_l, float* bg, const float* part, int np, float pscale, float* soutS) {
    float wb[16][8];
    if (WITH_BG) {
#pragma unroll
        for (int c = 0; c < 4; ++c)
#pragma unroll
            for (int e = 0; e < 4; ++e) {
                const float* wp = win_l + (size_t)(c * 256 + C.lane * 4 + e) * NINSRC + 2816;
                const f32x4 a = *(const f32x4*)wp, b = *(const f32x4*)(wp + 4);
                wb[c * 4 + e][0] = a[0]; wb[c * 4 + e][1] = a[1]; wb[c * 4 + e][2] = a[2]; wb[c * 4 + e][3] = a[3];
                wb[c * 4 + e][4] = b[0]; wb[c * 4 + e][5] = b[1]; wb[c * 4 + e][6] = b[2]; wb[c * 4 + e][7] = b[3];
            }
    }
    f32x4 nv[4];
    { const int row = C.bid * 8 + C.wave;
      if (row < TT) { const float* x = row < TP ? inP + (size_t)row * DM : inS + (size_t)(row - TP) * DM;
#pragma unroll
        for (int c = 0; c < 4; ++c) nv[c] = *(const f32x4*)(x + c * 256 + C.lane * 4); } }
    for (int row = C.bid * 8 + C.wave; row < TT; row += C.G * 8) {
        f32x4 v[4]; float ss = 0.f;
#pragma unroll
        for (int c = 0; c < 4; ++c) v[c] = nv[c];
        { const int r2 = row + C.G * 8;
          if (r2 < TT) { const float* x2 = r2 < TP ? inP + (size_t)r2 * DM : inS + (size_t)(r2 - TP) * DM;
#pragma unroll
            for (int c = 0; c < 4; ++c) nv[c] = *(const f32x4*)(x2 + c * 256 + C.lane * 4); } }
        if (row >= TP && np > 0) {
            f32x4 a[4];
#pragma unroll
            for (int c = 0; c < 4; ++c) a[c] = (f32x4){0.f, 0.f, 0.f, 0.f};
            for (int i = 0; i < np; ++i) {
                const float* pp = part + ((size_t)i * TS + (row - TP)) * DM + C.lane * 4;
#pragma unroll
                for (int c = 0; c < 4; ++c) a[c] += *(const f32x4*)(pp + c * 256);
            }
#pragma unroll
            for (int c = 0; c < 4; ++c) { v[c] += pscale * a[c]; *(f32x4*)(soutS + (size_t)(row - TP) * DM + c * 256 + C.lane * 4) = v[c]; }
        }
#pragma unroll
        for (int c = 0; c < 4; ++c) ss += v[c][0] * v[c][0] + v[c][1] * v[c][1] + v[c][2] * v[c][2] + v[c][3] * v[c][3];
        ss = wave_sum(ss);
        const float rs = rsqrtf(ss * (1.0f / 1024.0f) + EPS);
        float d[8];
        if (WITH_BG) {
#pragma unroll
            for (int q = 0; q < 8; ++q) d[q] = 0.f;
        }
#pragma unroll
        for (int c = 0; c < 4; ++c) {
            const f32x4 wv = *(const f32x4*)(w + c * 256 + C.lane * 4);
            f32x4 y = v[c] * rs * wv;
            u32x2 o; o.x = pk2(y[0], y[1]); o.y = pk2(y[2], y[3]);
            *(u32x2*)(xn + (size_t)row * DM + c * 256 + C.lane * 4) = o;
            if (WITH_BG) {
#pragma unroll
                for (int e = 0; e < 4; ++e)
#pragma unroll
                    for (int q = 0; q < 8; ++q) d[q] += y[e] * wb[c * 4 + e][q];
            }
        }
        if (WITH_BG) {
#pragma unroll
            for (int q = 0; q < 8; ++q) d[q] = wave_sum(d[q]);
            if (C.lane == 0) { *(f32x4*)(bg + (size_t)row * 8) = (f32x4){d[0], d[1], d[2], d[3]}; *(f32x4*)(bg + (size_t)row * 8 + 4) = (f32x4){d[4], d[5], d[6], d[7]}; }
        }
    }
}

__device__ __forceinline__ void finalize_od(const Ctx& C, const float* odf, const bf16_t* P, const float* onw, bf16_t* od) {
    const int e0 = (C.lane & 15) * 8;
    const f32x4 w0 = *(const f32x4*)(onw + e0), w1 = *(const f32x4*)(onw + e0 + 4);
    f32x4 na, nb; u32x4 nz;
    { const int row = C.bid * 8 + C.wave;
      if (row < TP) { const float* op = odf + (size_t)row * 512 + C.lane * 8; na = *(const f32x4*)op; nb = *(const f32x4*)(op + 4); nz = *(const u32x4*)(P + (size_t)row * NIN + PC_Z + C.lane * 8); } }
    for (int row = C.bid * 8 + C.wave; row < TP; row += C.G * 8) {
        const f32x4 a = na, b = nb; const u32x4 z = nz;
        { const int r2 = row + C.G * 8;
          if (r2 < TP) { const float* op = odf + (size_t)r2 * 512 + C.lane * 8; na = *(const f32x4*)op; nb = *(const f32x4*)(op + 4); nz = *(const u32x4*)(P + (size_t)r2 * NIN + PC_Z + C.lane * 8); } }
        float ss = a[0] * a[0] + a[1] * a[1] + a[2] * a[2] + a[3] * a[3] + b[0] * b[0] + b[1] * b[1] + b[2] * b[2] + b[3] * b[3];
        ss += __shfl_xor(ss, 1); ss += __shfl_xor(ss, 2); ss += __shfl_xor(ss, 4); ss += __shfl_xor(ss, 8);
        const float rs = rsqrtf(ss * (1.0f / 128.0f) + EPS);
        u32x4 o;
        o.x = pk2(a[0] * rs * w0[0] * siluf_(bflo(z.x)), a[1] * rs * w0[1] * siluf_(bfhi(z.x)));
        o.y = pk2(a[2] * rs * w0[2] * siluf_(bflo(z.y)), a[3] * rs * w0[3] * siluf_(bfhi(z.y)));
        o.z = pk2(b[0] * rs * w1[0] * siluf_(bflo(z.z)), b[1] * rs * w1[1] * siluf_(bfhi(z.z)));
        o.w = pk2(b[2] * rs * w1[2] * siluf_(bflo(z.w)), b[3] * rs * w1[3] * siluf_(bfhi(z.w)));
        *(u32x4*)(od + (size_t)row * 1024 + 512 + C.lane * 8) = o;
    }
}

__device__ __forceinline__ void attn_prompt_unit(const Ctx& C, int unit, const bf16_t* P, const float* sinks_l, bf16_t* OA) {
    const int kvh = unit & 1, qb = (unit >> 1) & 15, b = unit >> 5;
    LAS unsigned char* Ks = C.lds;
    LAS unsigned char* Vt = C.lds + 36864;
    const int tok0 = b * 2048 + qb * 128 - 128;
    bf16x8 qfa[2][2][2];
    {
        const int g_ = C.wave >> 1, hq_ = C.wave & 1, h_ = kvh * 4 + g_, fr_ = C.lane & 15, fq_ = C.lane >> 4;
#pragma unroll
        for (int it = 0; it < 2; ++it)
#pragma unroll
            for (int qt = 0; qt < 2; ++qt)
#pragma unroll
                for (int kk = 0; kk < 2; ++kk)
                    qfa[it][qt][kk] = *(const bf16x8*)(P + (size_t)(b * 2048 + qb * 128 + hq_ * 64 + it * 32 + qt * 16 + fr_) * NIN + PC_Q + h_ * 64 + kk * 32 + fq_ * 8);
    }
#pragma unroll
    for (int p = 0; p < 4; ++p) {
        const int id = C.tid + p * 512, r = id >> 3, ch = id & 7;
        const bool ok = (qb > 0) || (r >= 128);
        u32x4 kv = (u32x4){0u, 0u, 0u, 0u}, vv = (u32x4){0u, 0u, 0u, 0u};
        if (ok) { const bf16_t* rp = P + (size_t)(tok0 + r) * NIN; kv = *(const u32x4*)(rp + PC_K + kvh * 64 + ch * 8); vv = *(const u32x4*)(rp + PC_V + kvh * 64 + ch * 8); }
        *(LAS u32x4*)(Ks + r * 144 + ch * 16) = kv;
        LAS bf16_t* vt = (LAS bf16_t*)(Vt + (ch * 8) * 528 + r * 2);
        vt[0 * 264] = (bf16_t)(vv.x & 0xffff); vt[1 * 264] = (bf16_t)(vv.x >> 16); vt[2 * 264] = (bf16_t)(vv.y & 0xffff); vt[3 * 264] = (bf16_t)(vv.y >> 16);
        vt[4 * 264] = (bf16_t)(vv.z & 0xffff); vt[5 * 264] = (bf16_t)(vv.z >> 16); vt[6 * 264] = (bf16_t)(vv.w & 0xffff); vt[7 * 264] = (bf16_t)(vv.w >> 16);
    }
    __syncthreads();
    const int g = C.wave >> 1, hq = C.wave & 1, h = kvh * 4 + g, fr = C.lane & 15, fq = C.lane >> 4;
    const float sink = sinks_l[h];
#pragma unroll 1
    for (int it = 0; it < 2; ++it) {
        const int tq0 = hq * 64 + it * 32, jb0 = tq0;
        bf16x8 qf[2][2];
#pragma unroll
        for (int qt = 0; qt < 2; ++qt)
#pragma unroll
            for (int kk = 0; kk < 2; ++kk) qf[qt][kk] = it == 0 ? qfa[0][qt][kk] : qfa[1][qt][kk];
        f32x4 st[2][10];
#pragma unroll
        for (int kt = 0; kt < 10; ++kt) {
            st[0][kt] = (f32x4){0.f, 0.f, 0.f, 0.f}; st[1][kt] = (f32x4){0.f, 0.f, 0.f, 0.f};
#pragma unroll
            for (int kk = 0; kk < 2; ++kk) {
                const bf16x8 kf = *(const LAS bf16x8*)(Ks + (jb0 + kt * 16 + fr) * 144 + (kk * 32 + fq * 8) * 2);
                st[0][kt] = __builtin_amdgcn_mfma_f32_16x16x32_bf16(kf, qf[0][kk], st[0][kt], 0, 0, 0);
                st[1][kt] = __builtin_amdgcn_mfma_f32_16x16x32_bf16(kf, qf[1][kk], st[1][kt], 0, 0, 0);
            }
        }
        bf16x8 pb[2][5]; float linv[2];
#pragma unroll
        for (int qt = 0; qt < 2; ++qt) {
            const int tq = tq0 + qt * 16 + fr;
            float mx = sink;
#pragma unroll
            for (int kt = 0; kt < 10; ++kt)
#pragma unroll
                for (int j = 0; j < 4; ++j) {
                    const int jb = jb0 + kt * 16 + fq * 4 + j, rel = 128 + tq - jb;
                    const bool ok = rel >= 0 && rel <= 128 && (qb > 0 || jb >= 128);
                    const float s = ok ? st[qt][kt][j] : -INFINITY;
                    st[qt][kt][j] = s; mx = fmaxf(mx, s);
                }
            mx = fmaxf(mx, __shfl_xor(mx, 16)); mx = fmaxf(mx, __shfl_xor(mx, 32));
            float l = 0.f;
#pragma unroll
            for (int kt = 0; kt < 10; ++kt)
#pragma unroll
                for (int j = 0; j < 4; ++j) { const float p = __expf(st[qt][kt][j] - mx); st[qt][kt][j] = p; l += p; }
            l += __shfl_xor(l, 16); l += __shfl_xor(l, 32);
            l += __expf(sink - mx);
            linv[qt] = 1.0f / l;
#pragma unroll
            for (int sl = 0; sl < 5; ++sl) {
                const f32x4 p0 = st[qt][2 * sl], p1 = st[qt][2 * sl + 1];
                u32x4 w; w.x = pk2(p0[0], p0[1]); w.y = pk2(p0[2], p0[3]); w.z = pk2(p1[0], p1[1]); w.w = pk2(p1[2], p1[3]);
                pb[qt][sl] = __builtin_bit_cast(bf16x8, w);
            }
        }
        f32x4 ot[2][4];
#pragma unroll
        for (int dt = 0; dt < 4; ++dt) { ot[0][dt] = (f32x4){0.f, 0.f, 0.f, 0.f}; ot[1][dt] = (f32x4){0.f, 0.f, 0.f, 0.f}; }
#pragma unroll
        for (int sl = 0; sl < 5; ++sl)
#pragma unroll
            for (int dt = 0; dt < 4; ++dt) {
                const LAS unsigned char* vp = Vt + (dt * 16 + fr) * 528 + (jb0 + sl * 32 + fq * 4) * 2;
                const u32x2 v0 = *(const LAS u32x2*)vp, v1 = *(const LAS u32x2*)(vp + 32);
                const u32x4 vw = (u32x4){v0.x, v0.y, v1.x, v1.y};
                const bf16x8 vf = __builtin_bit_cast(bf16x8, vw);
                ot[0][dt] = __builtin_amdgcn_mfma_f32_16x16x32_bf16(vf, pb[0][sl], ot[0][dt], 0, 0, 0);
                ot[1][dt] = __builtin_amdgcn_mfma_f32_16x16x32_bf16(vf, pb[1][sl], ot[1][dt], 0, 0, 0);
            }
#pragma unroll
        for (int qt = 0; qt < 2; ++qt) {
            bf16_t* op = OA + (size_t)(b * 2048 + qb * 128 + tq0 + qt * 16 + fr) * 1024 + h * 64 + fq * 4;
#pragma unroll
            for (int dt = 0; dt < 4; ++dt) {
                const f32x4 o = ot[qt][dt] * linv[qt];
                u32x2 w; w.x = pk2(o[0], o[1]); w.y = pk2(o[2], o[3]);
                *(u32x2*)(op + dt * 16) = w;
            }
        }
    }
    __syncthreads();
}

__device__ __forceinline__ void attn_sample_task(const Ctx& C, int task, int l, PK p, const bf16_t* P, bf16_t* OA) {
    const int b = task >> 3, h = task & 7, kvh = h >> 2, lane = C.lane;
    const size_t row = (size_t)TP + b;
    const float* ck = p->cache_k + ((size_t)(l * 128 + b) * 128) * 128 + kvh * 64;
    const float* cv = p->cache_v + ((size_t)(l * 128 + b) * 128) * 128 + kvh * 64;
    u32x4 qw[8];
#pragma unroll
    for (int i = 0; i < 8; ++i) qw[i] = *(const u32x4*)(P + row * NIN + PC_Q + h * 64 + i * 8);
    float s0 = 0.f, s1 = 0.f, s2 = 0.f;
    {
        const float* k0 = ck + (size_t)lane * 128; const float* k1 = ck + (size_t)(lane + 64) * 128;
#pragma unroll
        for (int i = 0; i < 8; ++i) {
            const f32x4 a0 = *(const f32x4*)(k0 + i * 8), a1 = *(const f32x4*)(k0 + i * 8 + 4), b0 = *(const f32x4*)(k1 + i * 8), b1 = *(const f32x4*)(k1 + i * 8 + 4);
            const float q0 = bflo(qw[i].x), q1 = bfhi(qw[i].x), q2 = bflo(qw[i].y), q3 = bfhi(qw[i].y), q4 = bflo(qw[i].z), q5 = bfhi(qw[i].z), q6 = bflo(qw[i].w), q7 = bfhi(qw[i].w);
            s0 += q0 * a0[0] + q1 * a0[1] + q2 * a0[2] + q3 * a0[3] + q4 * a1[0] + q5 * a1[1] + q6 * a1[2] + q7 * a1[3];
            s1 += q0 * b0[0] + q1 * b0[1] + q2 * b0[2] + q3 * b0[3] + q4 * b1[0] + q5 * b1[1] + q6 * b1[2] + q7 * b1[3];
            const u32x4 kn = *(const u32x4*)(P + row * NIN + PC_K + kvh * 64 + i * 8);
            s2 += q0 * bflo(kn.x) + q1 * bfhi(kn.x) + q2 * bflo(kn.y) + q3 * bfhi(kn.y) + q4 * bflo(kn.z) + q5 * bfhi(kn.z) + q6 * bflo(kn.w) + q7 * bfhi(kn.w);
        }
    }
    const float sink = p->sinks[l * 8 + h];
    float mx = fmaxf(fmaxf(s0, s1), fmaxf(s2, sink));
#pragma unroll
    for (int o = 1; o < 64; o <<= 1) mx = fmaxf(mx, __shfl_xor(mx, o));
    const float p0 = __expf(s0 - mx), p1 = __expf(s1 - mx), p2 = __expf(s2 - mx);
    const float lsum = wave_sum(p0 + p1) + p2 + __expf(sink - mx);
    float o = p2 * bf1(P[row * NIN + PC_V + kvh * 64 + lane]);
    for (int j = 0; j < 64; ++j) {
        const float pa = __shfl(p0, j), pbv = __shfl(p1, j);
        o += pa * cv[(size_t)j * 128 + lane] + pbv * cv[(size_t)(j + 64) * 128 + lane];
    }
    OA[row * 1024 + h * 64 + lane] = (bf16_t)f2bf(o / lsum);
    if ((h & 3) == 0) {
        float* ok = p->out + O_KS + ((size_t)(l * 128 + b) * 128) * 128 + kvh * 64;
        float* ov = p->out + O_VS + ((size_t)(l * 128 + b) * 128) * 128 + kvh * 64;
        for (int j = 0; j < 127; ++j) { __builtin_nontemporal_store(ck[(size_t)(j + 1) * 128 + lane], ok + (size_t)j * 128 + lane); __builtin_nontemporal_store(cv[(size_t)(j + 1) * 128 + lane], ov + (size_t)j * 128 + lane); }
        ok[(size_t)127 * 128 + lane] = bf1(P[row * NIN + PC_K + kvh * 64 + lane]); ov[(size_t)127 * 128 + lane] = bf1(P[row * NIN + PC_V + kvh * 64 + lane]);
    }
}

__device__ __forceinline__ void dn_sample_task(const Ctx& C, int task, int l, PK p, const bf16_t* P, const float* BG, bf16_t* OD) {
    const int b = task >> 2, h = task & 3, tid = C.tid;
    const size_t row = (size_t)TP + b;
    LAS float* sq = (LAS float*)C.lds;
    LAS float* red = sq + 384;
    LAS float* scal = red + 512;
    const float* sc = p->state_conv + (size_t)(l * 128 + b) * 3 * 1536;
    float s[32];
    {
        const float* S0h = p->state_dn + ((size_t)(l * 128 + b) * 4 + h) * 16384 + (size_t)(tid >> 7) * 32 * 128 + (tid & 127);
#pragma unroll
        for (int dd = 0; dd < 32; ++dd) s[dd] = __builtin_nontemporal_load(S0h + (size_t)dd * 128);
    }
    if (tid < 384) {
        const int which = tid >> 7, ch = tid & 127, c = which * 512 + h * 128 + ch;
        const float* cw = p->conv_w + (size_t)l * 4 * 1536 + c;
        const float x0 = sc[c], x1 = sc[1536 + c], x2 = sc[3072 + c], x3 = bf1(P[row * NIN + PC_RAW + c]);
        const float y = x0 * cw[0] + x1 * cw[1536] + x2 * cw[3072] + x3 * cw[4608];
        sq[which * 128 + ch] = siluf_(y);
        float* oc = p->out + O_CVS + (size_t)(l * 128 + b) * 3 * 1536;
        oc[c] = x1; oc[1536 + c] = x2; oc[3072 + c] = x3;
    }
    __syncthreads();
    if (C.wave < 2) {
        const float a = sq[C.wave * 128 + C.lane], bq = sq[C.wave * 128 + 64 + C.lane];
        const float ssum = wave_sum(a * a + bq * bq);
        if (C.lane == 0) scal[C.wave] = rsqrtf(ssum + EPS);
    }
    __syncthreads();
    const float qsc = scal[0] * 0.08838834764831845f, ksc = scal[1];
    const float beta = sigmoidf_(BG[row * 8 + h]);
    const float gdec = __expf(-__expf(p->A_log[l * 4 + h]) * softplusf_(BG[row * 8 + 4 + h] + p->dt_bias[l * 4 + h]));
    const int e = tid & 127, dq = tid >> 7;
    const float* S0 = p->state_dn + ((size_t)(l * 128 + b) * 4 + h) * 16384;
    float* So = p->out + O_DNS + ((size_t)(l * 128 + b) * 4 + h) * 16384;
    float pred = 0.f;
#pragma unroll
    for (int dd = 0; dd < 32; ++dd) { const int d = dq * 32 + dd; s[dd] *= gdec; pred += sq[128 + d] * ksc * s[dd]; }
    red[dq * 128 + e] = pred;
    __syncthreads();
    const float predt = red[e] + red[128 + e] + red[256 + e] + red[384 + e];
    const float delta = beta * (sq[256 + e] - predt);
    float o = 0.f;
#pragma unroll
    for (int dd = 0; dd < 32; ++dd) { const int d = dq * 32 + dd; s[dd] += sq[128 + d] * ksc * delta; __builtin_nontemporal_store(s[dd], So + (size_t)d * 128 + e); o += sq[d] * qsc * s[dd]; }
    __syncthreads();
    red[dq * 128 + e] = o;
    __syncthreads();
    if (tid < 128) {
        const float ot = red[e] + red[128 + e] + red[256 + e] + red[384 + e];
        const float ssum = wave_sum(ot * ot);
        if (C.lane == 0) scal[2 + C.wave] = ssum;
        sq[e] = ot;
    }
    __syncthreads();
    if (tid < 128) {
        const float rs = rsqrtf((scal[2] + scal[3]) * (1.0f / 128.0f) + EPS);
        const float z = bf1(P[row * NIN + PC_Z + h * 128 + e]);
        OD[row * 1024 + 512 + h * 128 + e] = (bf16_t)f2bf(sq[e] * rs * p->dn_out_norm[l * 128 + e] * siluf_(z));
    }
    __syncthreads();
}

__device__ __forceinline__ void dn_pre_unit(const Ctx& C, int unit, int l, PK p, const bf16_t* P, const float* BG) {
    const int h = unit & 3, n = (unit >> 2) & 31, b = unit >> 7;
    const int tid = C.tid, lane = C.lane, w = C.wave, fr = lane & 15, fq = lane >> 4;
    LAS unsigned char* Ks = C.lds;
    LAS unsigned char* Qs = C.lds + 17408;
    LAS unsigned char* Vt = C.lds + 34816;
    LAS unsigned char* KtW = C.lds + 53248;
    LAS unsigned char* KdT = C.lds + 71680;
    LAS float* A2 = (LAS float*)(C.lds + 90112);
    LAS unsigned char* Ts = C.lds + 106496;
    LAS float* sG = (LAS float*)(C.lds + 115712);
    LAS float* sB = sG + 64;
    unsigned char* ws = p->ws;
    float* UT = (float*)(ws + WS_UT) + (size_t)unit * 8192;
    bf16_t* WN = (bf16_t*)(ws + WS_WN) + (size_t)unit * 8192;
    bf16_t* QD = (bf16_t*)(ws + WS_QD) + (size_t)unit * 8192;
    bf16_t* KDT = (bf16_t*)(ws + WS_KDT) + (size_t)unit * 8192;
    bf16_t* QK = (bf16_t*)(ws + WS_QK) + (size_t)unit * 4096;
    const int row0 = b * 2048 + n * 64;
    u32x4 pre[2][4][2];
    {
        const int t = tid >> 3, ch0 = (tid & 7) * 16;
#pragma unroll
        for (int which = 0; which < 2; ++which)
#pragma unroll
            for (int i = 0; i < 4; ++i) {
                const int tt = n * 64 + t - 3 + i;
                pre[which][i][0] = (u32x4){0u, 0u, 0u, 0u}; pre[which][i][1] = (u32x4){0u, 0u, 0u, 0u};
                if (tt >= 0) { const bf16_t* rp = P + (size_t)(b * 2048 + tt) * NIN + PC_RAW + which * 512 + h * 128 + ch0; pre[which][i][0] = *(const u32x4*)rp; pre[which][i][1] = *(const u32x4*)(rp + 8); }
            }
    }
    if (w == 0) {
        const float bb = BG[(size_t)(row0 + lane) * 8 + h], aa = BG[(size_t)(row0 + lane) * 8 + 4 + h];
        const float beta = sigmoidf_(bb);
        float gsum = -__expf(p->A_log[l * 4 + h]) * softplusf_(aa + p->dt_bias[l * 4 + h]);
#pragma unroll
        for (int o = 1; o < 64; o <<= 1) { const float t = __shfl_up(gsum, o); if (lane >= o) gsum += t; }
        sG[lane] = gsum; sB[lane] = beta;
        if (lane == 63) ((float*)(ws + WS_GL))[unit] = __expf(gsum);
    }
    __syncthreads();
    for (int r2_ = 0; r2_ < 1 + ((SUBREP >> 8) & 1); ++r2_)
    {
        const int t = tid >> 3, ch0 = (tid & 7) * 16;
        const float Gt = sG[t], bt = sB[t], eG = __expf(Gt), eGl = __expf(sG[63] - Gt);
#pragma unroll
        for (int which = 0; which < 3; ++which) {
            const int c = which * 512 + h * 128 + ch0;
            float y[16];
#pragma unroll
            for (int q = 0; q < 16; ++q) y[q] = 0.f;
#pragma unroll
            for (int i = 0; i < 4; ++i) {
                const int tt = n * 64 + t - 3 + i;
                if (tt >= 0) {
                    u32x4 x0, x1;
                    if (which < 2) { x0 = pre[which < 2 ? which : 0][i][0]; x1 = pre[which < 2 ? which : 0][i][1]; }
                    else { const bf16_t* rp = P + (size_t)(b * 2048 + tt) * NIN + PC_RAW + c; x0 = *(const u32x4*)rp; x1 = *(const u32x4*)(rp + 8); }
                    const float* cw = p->conv_w + ((size_t)l * 4 + i) * 1536 + c;
                    const f32x4 w0 = *(const f32x4*)cw, w1 = *(const f32x4*)(cw + 4), w2 = *(const f32x4*)(cw + 8), w3 = *(const f32x4*)(cw + 12);
                    y[0] += bflo(x0.x) * w0[0]; y[1] += bfhi(x0.x) * w0[1]; y[2] += bflo(x0.y) * w0[2]; y[3] += bfhi(x0.y) * w0[3];
                    y[4] += bflo(x0.z) * w1[0]; y[5] += bfhi(x0.z) * w1[1]; y[6] += bflo(x0.w) * w1[2]; y[7] += bfhi(x0.w) * w1[3];
                    y[8] += bflo(x1.x) * w2[0]; y[9] += bfhi(x1.x) * w2[1]; y[10] += bflo(x1.y) * w2[2]; y[11] += bfhi(x1.y) * w2[3];
                    y[12] += bflo(x1.z) * w3[0]; y[13] += bfhi(x1.z) * w3[1]; y[14] += bflo(x1.w) * w3[2]; y[15] += bfhi(x1.w) * w3[3];
                }
            }
            float ss = 0.f;
#pragma unroll
            for (int q = 0; q < 16; ++q) { y[q] = siluf_(y[q]); ss += y[q] * y[q]; }
            if (which < 2) { ss += __shfl_xor(ss, 1); ss += __shfl_xor(ss, 2); ss += __shfl_xor(ss, 4); }
            if (which == 0) {
                const float sc = rsqrtf(ss + EPS) * 0.08838834764831845f;
                u32x4 a, d2, qa, qb2;
                a.x = pk2(y[0] * sc, y[1] * sc); a.y = pk2(y[2] * sc, y[3] * sc); a.z = pk2(y[4] * sc, y[5] * sc); a.w = pk2(y[6] * sc, y[7] * sc);
                d2.x = pk2(y[8] * sc, y[9] * sc); d2.y = pk2(y[10] * sc, y[11] * sc); d2.z = pk2(y[12] * sc, y[13] * sc); d2.w = pk2(y[14] * sc, y[15] * sc);
                *(LAS u32x4*)(Qs + t * 272 + ch0 * 2) = a; *(LAS u32x4*)(Qs + t * 272 + ch0 * 2 + 16) = d2;
                const float s2 = sc * eG;
                qa.x = pk2(y[0] * s2, y[1] * s2); qa.y = pk2(y[2] * s2, y[3] * s2); qa.z = pk2(y[4] * s2, y[5] * s2); qa.w = pk2(y[6] * s2, y[7] * s2);
                qb2.x = pk2(y[8] * s2, y[9] * s2); qb2.y = pk2(y[10] * s2, y[11] * s2); qb2.z = pk2(y[12] * s2, y[13] * s2); qb2.w = pk2(y[14] * s2, y[15] * s2);
                *(u32x4*)(QD + t * 128 + ch0) = qa; *(u32x4*)(QD + t * 128 + ch0 + 8) = qb2;
            } else if (which == 1) {
                const float sc = rsqrtf(ss + EPS);
                u32x4 a, d2;
                a.x = pk2(y[0] * sc, y[1] * sc); a.y = pk2(y[2] * sc, y[3] * sc); a.z = pk2(y[4] * sc, y[5] * sc); a.w = pk2(y[6] * sc, y[7] * sc);
                d2.x = pk2(y[8] * sc, y[9] * sc); d2.y = pk2(y[10] * sc, y[11] * sc); d2.z = pk2(y[12] * sc, y[13] * sc); d2.w = pk2(y[14] * sc, y[15] * sc);
                *(LAS u32x4*)(Ks + t * 272 + ch0 * 2) = a; *(LAS u32x4*)(Ks + t * 272 + ch0 * 2 + 16) = d2;
                const float s1 = sc * bt * eG, s3 = sc * eGl;
#pragma unroll
                for (int q = 0; q < 16; ++q) {
                    *(LAS bf16_t*)(KtW + (ch0 + q) * 144 + t * 2) = (bf16_t)f2bf(y[q] * s1);
                    *(LAS bf16_t*)(KdT + (ch0 + q) * 144 + t * 2) = (bf16_t)f2bf(y[q] * s3);
                }
            } else {
#pragma unroll
                for (int q = 0; q < 16; ++q) *(LAS bf16_t*)(Vt + (ch0 + q) * 144 + t * 2) = (bf16_t)f2bf(y[q] * bt);
            }
        }
    }
    __syncthreads();
    {
        const int itile = w & 3; const bool isq = w >= 4;
        LAS unsigned char* Arows = isq ? Qs : Ks;
        bf16x8 af[4];
#pragma unroll
        for (int k4 = 0; k4 < 4; ++k4) af[k4] = *(const LAS bf16x8*)(Arows + (itile * 16 + fr) * 272 + (k4 * 32 + fq * 8) * 2);
#pragma unroll
        for (int jt = 0; jt < 4; ++jt) {
            f32x4 acc = (f32x4){0.f, 0.f, 0.f, 0.f};
#pragma unroll
            for (int k4 = 0; k4 < 4; ++k4) {
                const bf16x8 bfv = *(const LAS bf16x8*)(Ks + (jt * 16 + fr) * 272 + (k4 * 32 + fq * 8) * 2);
                acc = __builtin_amdgcn_mfma_f32_16x16x32_bf16(af[k4], bfv, acc, 0, 0, 0);
            }
            const int j = jt * 16 + fr; const float Gj = sG[j];
#pragma unroll
            for (int jj = 0; jj < 4; ++jj) {
                const int i = itile * 16 + fq * 4 + jj;
                const float dec = __expf(sG[i] - Gj);
                if (!isq) A2[i * 64 + (j & 7) * 8 + (j >> 3)] = (j < i) ? sB[i] * acc[jj] * dec : 0.f;
                else *(LAS bf16_t*)(Qs + i * 272 + j * 2) = (bf16_t)f2bf((j <= i) ? acc[jj] * dec : 0.f);
            }
        }
    }
    __syncthreads();
    { const int r = tid >> 3, ch = tid & 7; *(u32x4*)(QK + r * 64 + ch * 8) = *(const LAS u32x4*)(Qs + r * 272 + ch * 16); }
    for (int r2_ = 0; r2_ < 1 + ((SUBREP >> 9) & 1); ++r2_)
    {
        const int c = w * 8 + (lane >> 3), jg = lane & 7;
        float tt[8];
#pragma unroll
        for (int q = 0; q < 8; ++q) tt[q] = 0.f;
        f32x4 na0 = *(const LAS f32x4*)(A2 + jg * 8), na1 = *(const LAS f32x4*)(A2 + jg * 8 + 4);
#pragma unroll 1
        for (int i = 0; i < 64; ++i) {
            const f32x4 a0 = na0, a1 = na1;
            { const int i2 = (i + 1) & 63; na0 = *(const LAS f32x4*)(A2 + i2 * 64 + jg * 8); na1 = *(const LAS f32x4*)(A2 + i2 * 64 + jg * 8 + 4); }
            float part = (a0[0] * tt[0] + a0[1] * tt[1]) + (a0[2] * tt[2] + a0[3] * tt[3]) + ((a1[0] * tt[4] + a1[1] * tt[5]) + (a1[2] * tt[6] + a1[3] * tt[7]));
            part += __builtin_bit_cast(float, __builtin_amdgcn_update_dpp(0, __builtin_bit_cast(int, part), 0xB1, 0xF, 0xF, true));
            part += __builtin_bit_cast(float, __builtin_amdgcn_update_dpp(0, __builtin_bit_cast(int, part), 0x4E, 0xF, 0xF, true));
            part += __builtin_bit_cast(float, __builtin_amdgcn_update_dpp(0, __builtin_bit_cast(int, part), 0x141, 0xF, 0xF, true));
            const float tv = ((i == c) ? 1.0f : 0.0f) - part;
            const bool mine = jg == (i & 7); const int qi = i >> 3;
#pragma unroll
            for (int q = 0; q < 8; ++q) tt[q] = (mine && q == qi) ? tv : tt[q];
        }
#pragma unroll
        for (int q = 0; q < 8; ++q) *(LAS bf16_t*)(Ts + (jg + 8 * q) * 144 + c * 2) = (bf16_t)f2bf(tt[q]);
    }
    __syncthreads();
    {
        bf16x8 va[2], ka[2];
#pragma unroll
        for (int k2 = 0; k2 < 2; ++k2) {
            va[k2] = *(const LAS bf16x8*)(Vt + (w * 16 + fr) * 144 + (k2 * 32 + fq * 8) * 2);
            ka[k2] = *(const LAS bf16x8*)(KtW + (w * 16 + fr) * 144 + (k2 * 32 + fq * 8) * 2);
        }
#pragma unroll
        for (int jt = 0; jt < 4; ++jt) {
            f32x4 au = (f32x4){0.f, 0.f, 0.f, 0.f}, aw = (f32x4){0.f, 0.f, 0.f, 0.f};
#pragma unroll
            for (int k2 = 0; k2 < 2; ++k2) {
                const bf16x8 tf = *(const LAS bf16x8*)(Ts + (jt * 16 + fr) * 144 + (k2 * 32 + fq * 8) * 2);
                au = __builtin_amdgcn_mfma_f32_16x16x32_bf16(va[k2], tf, au, 0, 0, 0);
                aw = __builtin_amdgcn_mfma_f32_16x16x32_bf16(tf, ka[k2], aw, 0, 0, 0);
            }
            *(f32x4*)(UT + ((size_t)(w * 4 + jt) * 64 + lane) * 4) = au;
#pragma unroll
            for (int jj = 0; jj < 4; ++jj) *(LAS bf16_t*)(Ks + (jt * 16 + fq * 4 + jj) * 272 + (w * 16 + fr) * 2) = (bf16_t)f2bf(-aw[jj]);
        }
#pragma unroll
        for (int pp = 0; pp < 2; ++pp) {
            const int id = tid + pp * 512, r = id >> 3, ch = id & 7;
            *(u32x4*)(KDT + r * 64 + ch * 8) = *(const LAS u32x4*)(KdT + r * 144 + ch * 16);
        }
    }
    __syncthreads();
#pragma unroll
    for (int pp = 0; pp < 2; ++pp) { const int id = tid + pp * 512, r = id >> 4, ch = id & 15; *(u32x4*)(WN + r * 128 + ch * 8) = *(const LAS u32x4*)(Ks + r * 272 + ch * 16); }
    __syncthreads();
}

struct ScanFrags { bf16x8 wn[4]; bf16x8 qd[4]; bf16x8 qk[2]; bf16x8 kd[1][2]; f32x4 ut; float gl; };
__device__ __forceinline__ void scan_load(ScanFrags& f, PK p, int unit, int s, int w, int lane) {
    const int fr = lane & 15, fq = lane >> 4, et = w >> 2, xt = w & 3;
    const unsigned char* ws = p->ws;
    const bf16_t* WN = (const bf16_t*)(ws + WS_WN) + (size_t)unit * 8192;
    const bf16_t* QD = (const bf16_t*)(ws + WS_QD) + (size_t)unit * 8192;
    const bf16_t* KDT = (const bf16_t*)(ws + WS_KDT) + (size_t)unit * 8192;
    const bf16_t* QK = (const bf16_t*)(ws + WS_QK) + (size_t)unit * 4096;
    const float* UT = (const float*)(ws + WS_UT) + (size_t)unit * 8192;
#pragma unroll
    for (int k4 = 0; k4 < 4; ++k4) { f.wn[k4] = *(const bf16x8*)(WN + (xt * 16 + fr) * 128 + k4 * 32 + fq * 8); f.qd[k4] = *(const bf16x8*)(QD + (xt * 16 + fr) * 128 + k4 * 32 + fq * 8); }
#pragma unroll
    for (int k2 = 0; k2 < 2; ++k2) { f.qk[k2] = *(const bf16x8*)(QK + (xt * 16 + fr) * 64 + k2 * 32 + fq * 8); f.kd[0][k2] = *(const bf16x8*)(KDT + (w * 16 + fr) * 64 + k2 * 32 + fq * 8); }
    f.ut = *(const f32x4*)(UT + ((size_t)((s * 2 + et) * 4 + xt) * 64 + lane) * 4);
    { int z_ = 0; asm volatile("" : "+v"(z_)); f.gl = ((const float*)(ws + WS_GL))[unit + z_]; }
}
#define LBAR() do { asm volatile("s_waitcnt lgkmcnt(0)" ::: "memory"); __builtin_amdgcn_s_barrier(); asm volatile("" ::: "memory"); } while (0)
struct ScanState { f32x4 sacc[2]; };
__device__ __forceinline__ void scan_step(const ScanFrags& cur, ScanState& S, LAS unsigned char* St, LAS unsigned char* uT, float* ODF, int b, int h, int s, int n, int w, int lane) {
    const int fr = lane & 15, fq = lane >> 4, et = w >> 2, xt = w & 3;
    bf16x8 sa[4];
#pragma unroll
    for (int k4 = 0; k4 < 4; ++k4) sa[k4] = *(const LAS bf16x8*)(St + (et * 16 + fr) * 272 + (k4 * 32 + fq * 8) * 2);
    f32x4 u = cur.ut;
#pragma unroll
    for (int k4 = 0; k4 < 4; ++k4) u = __builtin_amdgcn_mfma_f32_16x16x32_bf16(sa[k4], cur.wn[k4], u, 0, 0, 0);
#pragma unroll
    for (int jj = 0; jj < 4; ++jj) *(LAS bf16_t*)(uT + (et * 16 + fq * 4 + jj) * 144 + (xt * 16 + fr) * 2) = (bf16_t)f2bf(u[jj]);
    f32x4 o = (f32x4){0.f, 0.f, 0.f, 0.f};
#pragma unroll
    for (int k4 = 0; k4 < 4; ++k4) o = __builtin_amdgcn_mfma_f32_16x16x32_bf16(sa[k4], cur.qd[k4], o, 0, 0, 0);
    LBAR();
    bf16x8 ua[2];
#pragma unroll
    for (int k2 = 0; k2 < 2; ++k2) ua[k2] = *(const LAS bf16x8*)(uT + (et * 16 + fr) * 144 + (k2 * 32 + fq * 8) * 2);
#pragma unroll
    for (int k2 = 0; k2 < 2; ++k2) o = __builtin_amdgcn_mfma_f32_16x16x32_bf16(ua[k2], cur.qk[k2], o, 0, 0, 0);
    *(f32x4*)(ODF + (size_t)(b * 2048 + n * 64 + xt * 16 + fr) * 512 + h * 128 + s * 32 + et * 16 + fq * 4) = o;
#pragma unroll
    for (int e2 = 0; e2 < 2; ++e2) {
        bf16x8 ue[2];
#pragma unroll
        for (int k2 = 0; k2 < 2; ++k2) ue[k2] = *(const LAS bf16x8*)(uT + (e2 * 16 + fr) * 144 + (k2 * 32 + fq * 8) * 2);
        f32x4 a = S.sacc[e2] * cur.gl;
#pragma unroll
        for (int k2 = 0; k2 < 2; ++k2) a = __builtin_amdgcn_mfma_f32_16x16x32_bf16(ue[k2], cur.kd[0][k2], a, 0, 0, 0);
        S.sacc[e2] = a;
    }
    LBAR();
#pragma unroll
    for (int e2 = 0; e2 < 2; ++e2)
#pragma unroll
        for (int jj = 0; jj < 4; ++jj) *(LAS bf16_t*)(St + (e2 * 16 + fq * 4 + jj) * 272 + (w * 16 + fr) * 2) = (bf16_t)f2bf(S.sacc[e2][jj]);
    LBAR();
}
__device__ __forceinline__ void dn_scan(const Ctx& C, int l, PK p) {
    if (C.bid >= 128) return;
    const int q_ = C.bid >> 3, s = q_ & 3, chain = (C.bid & 7) + 8 * (q_ >> 2), b = chain >> 2, h = chain & 3;
    const int w = C.wave, lane = C.lane, fr = lane & 15, fq = lane >> 4;
    LAS unsigned char* St = C.lds;
    LAS unsigned char* uT = C.lds + 8704;
    float* ODF = (float*)(p->ws + WS_ODF);
    ScanState S;
    S.sacc[0] = (f32x4){0.f, 0.f, 0.f, 0.f}; S.sacc[1] = (f32x4){0.f, 0.f, 0.f, 0.f};
    for (int i = C.tid; i < 8704 / 4; i += 512) ((LAS unsigned*)St)[i] = 0u;
    ScanFrags fa, fb, fc;
    const int u0 = (b * 32) * 4 + h;
    scan_load(fa, p, u0, s, w, lane);
    scan_load(fb, p, u0 + 4, s, w, lane);
    __syncthreads();
#pragma unroll 1
    for (int n = 0; n < 33; n += 3) {
        if (n + 2 < 32) scan_load(fc, p, u0 + (n + 2) * 4, s, w, lane);
        scan_step(fa, S, St, uT, ODF, b, h, s, n, w, lane);
        if (n + 3 < 32) scan_load(fa, p, u0 + (n + 3) * 4, s, w, lane);
        scan_step(fb, S, St, uT, ODF, b, h, s, n + 1, w, lane);
        if (n + 2 >= 32) break;
        if (n + 4 < 32) scan_load(fb, p, u0 + (n + 4) * 4, s, w, lane);
        scan_step(fc, S, St, uT, ODF, b, h, s, n + 2, w, lane);
    }
    float* So = p->out + O_DNP + ((size_t)(l * 8 + b) * 4 + h) * 16384;
#pragma unroll
    for (int e2 = 0; e2 < 2; ++e2)
#pragma unroll
        for (int jj = 0; jj < 4; ++jj) So[(size_t)(w * 16 + fr) * 128 + s * 32 + e2 * 16 + fq * 4 + jj] = S.sacc[e2][jj];
}

__device__ __forceinline__ void sample_merge(const Ctx& C, const bf16_t* wa, const bf16_t* wd, const bf16_t* OA, const bf16_t* OD, const bf16_t* P, bf16_t* MRG) {
    const int ct = C.bid, rt = C.wave, fr = C.lane & 15, fq = C.lane >> 4;
    const int lc = ct * 16 + fr, lg = lc & 31;
    const int phys = (lc & ~31) + ((lg >> 2) & 1) * 16 + (lg >> 3) * 4 + (lg & 3);
    const bf16_t* war = wa + (size_t)phys * 1024 + fq * 8; const bf16_t* wdr = wa + (size_t)phys * 1024 + 512 + fq * 8; (void)wd;
    const size_t trow = (size_t)TP + rt * 16 + fr;
    const bf16_t* xar = OA + trow * 1024 + fq * 8; const bf16_t* xdr = OA + trow * 1024 + 512 + fq * 8; (void)OD;
    f32x4 aa = (f32x4){0.f, 0.f, 0.f, 0.f}, ad = (f32x4){0.f, 0.f, 0.f, 0.f};
#pragma unroll 4
    for (int k = 0; k < 16; ++k) {
        const bf16x8 wfa = *(const bf16x8*)(war + k * 32), wfd = *(const bf16x8*)(wdr + k * 32);
        const bf16x8 xa = *(const bf16x8*)(xar + k * 32), xd = *(const bf16x8*)(xdr + k * 32);
        aa = __builtin_amdgcn_mfma_f32_16x16x32_bf16(wfa, xa, aa, 0, 0, 0);
        ad = __builtin_amdgcn_mfma_f32_16x16x32_bf16(wfd, xd, ad, 0, 0, 0);
    }
    const int col0 = ct * 16 + fq * 4;
    const u32x2 ga = *(const u32x2*)(P + trow * NIN + PC_GA + col0), gd = *(const u32x2*)(P + trow * NIN + PC_GD + col0);
    u32x2 w;
    w.x = pk2(sigmoidf_(bflo(ga.x)) * aa[0] + sigmoidf_(bflo(gd.x)) * ad[0], sigmoidf_(bfhi(ga.x)) * aa[1] + sigmoidf_(bfhi(gd.x)) * ad[1]);
    w.y = pk2(sigmoidf_(bflo(ga.y)) * aa[2] + sigmoidf_(bflo(gd.y)) * ad[2], sigmoidf_(bfhi(ga.y)) * aa[3] + sigmoidf_(bfhi(gd.y)) * ad[3]);
    *(u32x2*)(MRG + trow * DM + col0) = w;
}

#define XB_TMO      128
#define XB_XCNT(j)  (256  + 64 * (j))
#define XB_XSUB(j)  (1280 + 64 * (j))
#define XB_XGEN(j)  (2304 + 64 * (j))
#define XB_TOP      3328
#define XB_TOPGEN   3392
#define XCD_BAR_WORDS 3456
#define XB_SPIN_CAP (1u << 20)
__device__ __forceinline__ unsigned xb_ld(unsigned* p)              { return __hip_atomic_load(p, __ATOMIC_RELAXED, __HIP_MEMORY_SCOPE_AGENT); }
__device__ __forceinline__ unsigned xb_add(unsigned* p, unsigned v) { return __hip_atomic_fetch_add(p, v, __ATOMIC_RELAXED, __HIP_MEMORY_SCOPE_AGENT); }
__device__ __forceinline__ unsigned xb_xcc_id() { return (unsigned)__builtin_amdgcn_s_getreg((3 << 11) | 20) & 0xFu; }
#define XB_SPIN(cond, bar) do { unsigned _sp = 0; while (cond) { __builtin_amdgcn_s_sleep(1); \
    if ((++_sp & 255u) == 0u) { if (xb_ld(&(bar)[XB_TMO])) break; if (_sp > XB_SPIN_CAP) { atomicAdd(&(bar)[XB_TMO], 1u); break; } } } } while (0)
struct XcdBarrier { unsigned* bar; unsigned x; volatile LAS unsigned* st; };
__device__ __forceinline__ XcdBarrier xcd_barrier_post(unsigned* bar, volatile LAS unsigned* st) {
    XcdBarrier b; b.bar = bar; b.x = xb_xcc_id(); b.st = st;
    if (threadIdx.x == 0) (void)xb_add(&bar[XB_XCNT(b.x)], 1u);
    return b;
}
__device__ __forceinline__ void xcd_barrier_complete(unsigned* bar, unsigned x, unsigned& nloc, unsigned& nx) {
    const unsigned G = gridDim.x * gridDim.y * gridDim.z;
    unsigned sum, cnt, mine, sp = 0u;
    for (;;) {
        sum = 0u; cnt = 0u; mine = 0u;
#pragma unroll
        for (unsigned j = 0; j < 16; ++j) { const unsigned c = xb_ld(&bar[XB_XCNT(j)]); sum += c; cnt += (c > 0u) ? 1u : 0u; mine = (j == x) ? c : mine; }
        if (sum == G) break;
        __builtin_amdgcn_s_sleep(1);
        if ((++sp & 255u) == 0u) { if (xb_ld(&bar[XB_TMO])) break; if (sp > XB_SPIN_CAP) { atomicAdd(&bar[XB_TMO], 1u); break; } }
    }
    nloc = mine > 0u ? mine : 1u; nx = cnt > 0u ? cnt : 1u;
}
__device__ __forceinline__ void xcd_barrier(const XcdBarrier& b) {
    asm volatile("s_waitcnt vmcnt(0)" ::: "memory");
    __syncthreads();
    if (threadIdx.x == 0) {
        unsigned* bar = b.bar;
        __builtin_amdgcn_s_waitcnt(0);
        unsigned nloc = b.st[0], nx = b.st[1];
        if (nloc == 0u) { xcd_barrier_complete(bar, b.x, nloc, nx); b.st[0] = nloc; b.st[1] = nx; }
        const unsigned old = xb_add(&bar[XB_XSUB(b.x)], 1u);
        const unsigned gen = old / nloc;
        if (old + 1u == (gen + 1u) * nloc) {
            __builtin_amdgcn_fence(__ATOMIC_RELEASE, "agent");
            asm volatile("s_waitcnt vmcnt(0)" ::: "memory");
            const unsigned og = xb_add(&bar[XB_TOP], 1u);
            const unsigned tg = og / nx;
            if (og + 1u == (tg + 1u) * nx) xb_add(&bar[XB_TOPGEN], 1u);
            else XB_SPIN(xb_ld(&bar[XB_TOPGEN]) == tg, bar);
            __builtin_amdgcn_fence(__ATOMIC_ACQUIRE, "agent");
            xb_add(&bar[XB_XGEN(b.x)], 1u);
            asm volatile("s_waitcnt vmcnt(0)" ::: "memory");
        } else {
            XB_SPIN(xb_ld(&bar[XB_XGEN(b.x)]) == gen, bar);
            __builtin_amdgcn_fence(__ATOMIC_ACQUIRE, "agent");
            asm volatile("s_waitcnt vmcnt(0)" ::: "memory");
        }
    }
    __syncthreads();
}

#ifndef DISMASK
#define DISMASK 0
#endif
#define EN(x) (((DISMASK >> (x)) & 1) == 0)
#ifndef REPMASK
#define REPMASK 0
#endif
constexpr int NPH = 2 + 13 * DEPTH;
__global__ void __launch_bounds__(512, 2) fwd_megakernel(Params p_unused, int ph_lo, int ph_hi) {
    extern __shared__ __attribute__((aligned(16))) unsigned char lds_raw[];
    cg::grid_group grid = cg::this_grid();
    volatile LAS unsigned* MISC = (volatile LAS unsigned*)((LAS unsigned char*)lds_raw + LDS_BYTES - 64);
    if (threadIdx.x < 16) MISC[threadIdx.x] = 0u;
    __syncthreads();
    const XcdBarrier xbar = xcd_barrier_post((unsigned*)(((PK)__builtin_amdgcn_kernarg_segment_ptr())->ws + WS_BAR), MISC);
#pragma unroll 1
    for (int ph = ph_lo, rep = 0; ph < ph_hi;) {
        const __attribute__((address_space(4))) unsigned char* kp_ = (const __attribute__((address_space(4))) unsigned char*)__builtin_amdgcn_kernarg_segment_ptr();
        asm volatile("" : "+s"(kp_));
        PK p = (PK)kp_;
        unsigned char* ws = p->ws;
        int tid_ = threadIdx.x;
        asm volatile("" : "+v"(tid_));
        Ctx C; C.lds = (LAS unsigned char*)lds_raw; C.tid = tid_; C.lane = C.tid & 63; C.wave = __builtin_amdgcn_readfirstlane(C.tid >> 6); { int g_ = gridDim.x, b_ = blockIdx.x; asm volatile("" : "+s"(g_), "+s"(b_)); C.G = g_; C.bid = b_; }
        bf16_t* WB = (bf16_t*)(ws + WS_W);
        float* H = (float*)(ws + WS_H);
        bf16_t* XN = (bf16_t*)(ws + WS_XN);
        bf16_t* ACT = (bf16_t*)(ws + WS_ACT);
        float* TMP = (float*)(ws + WS_ACT);
        bf16_t* P = (bf16_t*)(ws + WS_P);
        bf16_t* OA = (bf16_t*)(ws + WS_OA);
        bf16_t* OD = (bf16_t*)(ws + WS_OA);
        float* BG = (float*)(ws + WS_BG);
        float2* ROPE = (float2*)(ws + WS_ROPE);
        float* YP = p->out + O_YP; float* YS = p->out + O_YS;
        if (ph == 0 && EN(13)) {
#pragma unroll 1
            for (int l = 0; l < DEPTH; ++l) {
                bf16_t* wl = WB + (size_t)l * WL_END;
                convert_weight(C, p->ffn1_gu + (size_t)l * DM * 5632, 5632, DM, 5632, 1, wl + WL_GU1);
                convert_weight(C, p->ffn1_dn + (size_t)l * FF * DM, DM, FF, DM, 0, wl + WL_DN1);
                convert_weight(C, p->w_in + (size_t)l * DM * NINSRC, NINSRC, DM, NIN, 2, wl + WL_WIN);
                convert_weight(C, p->w_attn_o + (size_t)l * 512 * DM, DM, 512, DM, 0, wl + WL_AO, 1024, 0);
                convert_weight(C, p->w_dn_o + (size_t)l * 512 * DM, DM, 512, DM, 0, wl + WL_AO, 1024, 512);
                convert_weight(C, p->w_out + (size_t)l * DM * DM, DM, DM, DM, 0, wl + WL_WO);
                convert_weight(C, p->ffn2_gu + (size_t)l * DM * 5632, 5632, DM, 5632, 1, wl + WL_GU2);
                convert_weight(C, p->ffn2_dn + (size_t)l * FF * DM, DM, FF, DM, 0, wl + WL_DN2);
            }
            for (int i = C.bid * 512 + C.tid; i < 2049 * 32; i += C.G * 512) {
                const int pi = i >> 5, fi = i & 31;
                const float inv = 1.0f / exp2f((float)fi * (13.287712379549449f / 32.0f));
                const float posf = pi < 2048 ? (float)pi : 8192.0f;
                const float angf = posf * inv;
                const double ang = (double)angf;
                const double r = ang - 6.283185307179586 * rint(ang * 0.15915494309189535);
                const float rf = (float)r;
                ROPE[i] = make_float2(__cosf(rf), __sinf(rf));
            }
        } else if (ph == NPH - 1) {
            const float* PART = (const float*)(ws + WS_PART); const float* HS = H + (size_t)TP * DM;
            for (int r = C.bid * 8 + C.wave; r < TS; r += C.G * 8) {
#pragma unroll
                for (int c = 0; c < 4; ++c) {
                    f32x4 a = (f32x4){0.f, 0.f, 0.f, 0.f};
                    for (int i = 0; i < 11; ++i) a += *(const f32x4*)(PART + ((size_t)i * TS + r) * DM + c * 256 + C.lane * 4);
                    *(f32x4*)(YS + (size_t)r * DM + c * 256 + C.lane * 4) = *(const f32x4*)(HS + (size_t)r * DM + c * 256 + C.lane * 4) + 0.5f * a;
                }
            }
        } else {
            const int l = (ph - 1) / 13, k = (ph - 1) % 13;
            const bf16_t* wl = WB + (size_t)l * WL_END;
            const float* XinP = l == 0 ? p->x_prompt : YP; const float* XinS = l == 0 ? p->x_sample : YS;
            float* HS = H + (size_t)TP * DM;
            float* PART = (float*)(ws + WS_PART);
            if (k == 0 && EN(0)) {
                norm_phase<false>(C, XinP, l == 0 ? XinS : HS, p->ffn1_norm + l * DM, XN, nullptr, nullptr, PART, l == 0 ? 0 : 11, 0.5f, YS);
            } else if ((k == 1 || k == 11) && EN(1)) {
                pg8::Gemm g{XN, wl + (k == 1 ? WL_GU1 : WL_GU2), MP, 5632, DM}; pg8::StaticOrder S; S.init(5632, DM, C.G, C.bid, 128, 22, 16); EpiSwiglu E{ACT}; pg8::gemm_phase(C.lds, g, S, E, C.tid);
            } else if ((k == 2 || k == 12 || k == 9) && EN(2)) {
                pg8::Gemm g{k == 9 ? XN : ACT, wl + (k == 2 ? WL_DN1 : (k == 12 ? WL_DN2 : WL_WO)), MP, DM, k == 9 ? DM : FF}; pg8::StaticOrder S; S.init(DM, k == 9 ? DM : FF, C.G, C.bid, 0, k == 9 ? 16 : 44, 4);
                EpiResid E{k == 2 ? XinP : H, k == 12 ? YP : H, k == 9 ? 1.0f : 0.5f, PART};
                pg8::gemm_phase(C.lds, g, S, E, C.tid);
            } else if (k == 3 && EN(3)) {
                norm_phase<true>(C, H, XinS, p->mix_norm + l * DM, XN, p->w_in + (size_t)l * DM * NINSRC, BG, PART, 11, 0.5f, HS);
            } else if (k == 4 && EN(4)) {
                pg8::Gemm g{XN, wl + WL_WIN, MP, NIN, DM}; pg8::StaticOrder S; S.init(NIN, DM, C.G, C.bid, 192, 19, 16);
                EpiWin E{P, p->q_norm + l * 64, p->k_norm + l * 64, ROPE};
                pg8::gemm_phase(C.lds, g, S, E, C.tid);
            } else if (k == 5 && EN(5)) {
                for (int r_ = 0; r_ < 1 + ((SUBREP >> 1) & 1); ++r_)
                for (int u = C.bid; u < 1024; u += C.G) dn_pre_unit(C, u, l, p, P, BG);
                __syncthreads();
                for (int r_ = 0; r_ < 1 + ((SUBREP >> 3) & 1); ++r_)
                for (int t = C.bid; t < 512; t += C.G) dn_sample_task(C, t, l, p, P, BG, OD);
                for (int i = C.bid * 512 + C.tid; i < 262144; i += C.G * 512) {
                    const int which = i >> 17, r = i & 131071, d = r & 63, kvh = (r >> 6) & 1, j = (r >> 7) & 127, b = r >> 14;
                    const size_t row = (size_t)b * 2048 + 1920 + j;
                    p->out[(which ? O_VP : O_KP) + (size_t)l * 131072 + r] = bf1(P[row * NIN + (which ? PC_V : PC_K) + kvh * 64 + d]);
                }
                for (int i = C.bid * 512 + C.tid; i < 36864; i += C.G * 512) {
                    const int c = i % 1536, j = (i / 1536) % 3, b = i / 4608;
                    const size_t row = (size_t)b * 2048 + 2045 + j;
                    p->out[O_CVP + (size_t)l * 36864 + i] = bf1(P[row * NIN + PC_RAW + c]);
                }
            } else if (k == 6 && EN(6)) {
                if (C.bid < 128 || C.G != 256) dn_scan(C, l, p);
                if (C.bid >= 128 || C.G != 256) {
                const int bid2 = C.G == 256 ? C.bid - 128 : C.bid, G2 = C.G == 256 ? 128 : C.G;
                for (int r_ = 0; r_ < 1 + ((SUBREP >> 0) & 1); ++r_)
                for (int u = bid2; u < 256; u += G2) attn_prompt_unit(C, u, P, p->sinks + l * 8, OA);
                for (int r_ = 0; r_ < 1 + ((SUBREP >> 2) & 1); ++r_)
                for (int t = bid2 * 8 + C.wave; t < 1024; t += G2 * 8) attn_sample_task(C, t, l, p, P, OA);
                }
            } else if (k == 7 && EN(7)) {
                if (C.bid < 64) sample_merge(C, wl + WL_AO, wl + WL_DO, OA, OD, P, XN);
                finalize_od(C, (const float*)(ws + WS_ODF), P, p->dn_out_norm + l * 128, OD);
            } else if (k == 8 && EN(8)) {
                pg8::Gemm g{OA, wl + WL_AO, MP, DM, 1024}; pg8::StaticOrder S; S.init(DM, 1024, C.G, C.bid, 0, 0, 16);
                EpiGateK E{P, XN};
                pg8::gemm_phase<EpiGateK, true>(C.lds, g, S, E, C.tid);
            } else if (k == 10 && EN(10)) {
                norm_phase<false>(C, H, HS, p->ffn2_norm + l * DM, XN, nullptr, nullptr, PART, 4, 1.0f, HS);
            }
        }
        { const int kk_ = ph == 0 ? 13 : (ph - 1) % 13;
          if (rep == 0 && ((REPMASK >> kk_) & 1)) { rep = 1; xcd_barrier(xbar); continue; } }
        rep = 0; ++ph;
        if (ph < ph_hi) { if (ph == 1) grid.sync(); else xcd_barrier(xbar); }
    }
}

extern "C" void kernel_launch(void* const* d_in, const int* in_sizes, int n_in, void* d_out, int out_size, void* d_ws, size_t ws_size, hipStream_t stream) {
    static int grid = 0;
    if (grid == 0) {
        if (n_in != 24 || ws_size < WS_END) { fprintf(stderr, "kernel_launch: unexpected n_in %d / ws_size %zu (need %zu)\n", n_in, ws_size, (size_t)WS_END); grid = -1; return; }
        int dev = 0, cus = 0, per_cu = 0;
        hipGetDevice(&dev);
        hipDeviceGetAttribute(&cus, hipDeviceAttributeMultiprocessorCount, dev);
        if (hipFuncSetAttribute((const void*)fwd_megakernel, hipFuncAttributeMaxDynamicSharedMemorySize, LDS_BYTES) != hipSuccess) { fprintf(stderr, "hipFuncSetAttribute failed\n"); grid = -1; return; }
        hipOccupancyMaxActiveBlocksPerMultiprocessor(&per_cu, (const void*)fwd_megakernel, 512, LDS_BYTES);
        (void)hipGetLastError();
        if (per_cu < 1) per_cu = 1;
        grid = cus;
    }
    if (grid < 0) return;
    if (hipMemsetAsync((char*)d_ws + WS_BAR, 0, 16384, stream) != hipSuccess) { fprintf(stderr, "memset failed\n"); return; }
    Params p{};
    const float* const* in = (const float* const*)d_in;
    p.x_prompt = in[0]; p.x_sample = in[1]; p.cache_k = in[2]; p.cache_v = in[3]; p.state_dn = in[4]; p.state_conv = in[5];
    p.ffn1_norm = in[6]; p.ffn1_gu = in[7]; p.ffn1_dn = in[8]; p.mix_norm = in[9]; p.w_in = in[10]; p.q_norm = in[11]; p.k_norm = in[12];
    p.sinks = in[13]; p.conv_w = in[14]; p.A_log = in[15]; p.dt_bias = in[16]; p.dn_out_norm = in[17]; p.w_attn_o = in[18]; p.w_dn_o = in[19];
    p.w_out = in[20]; p.ffn2_norm = in[21]; p.ffn2_gu = in[22]; p.ffn2_dn = in[23];
    p.out = (float*)d_out; p.ws = (unsigned char*)d_ws;
    int ph_lo = 0, ph_hi = NPH;
    void* args[] = {&p, &ph_lo, &ph_hi};
    hipError_t e = hipLaunchCooperativeKernel((const void*)fwd_megakernel, dim3(grid), dim3(512), args, LDS_BYTES, stream);
    if (e != hipSuccess) fprintf(stderr, "cooperative launch failed: %s (grid %d)\n", hipGetErrorString(e), grid);
}
```

```cpp
#include <hip/hip_runtime.h>
#include <hip/hip_cooperative_groups.h>
#include <cstdio>
#include <cstdint>
namespace cg = cooperative_groups;
#ifndef SUBREP
#define SUBREP 0
#endif

#define LAS __attribute__((address_space(3)))
typedef unsigned short bf16_t;
typedef short bf16x8 __attribute__((ext_vector_type(8)));
typedef float f32x4 __attribute__((ext_vector_type(4)));
typedef unsigned u32x4 __attribute__((ext_vector_type(4)));
typedef unsigned u32x2 __attribute__((ext_vector_type(2)));

constexpr int TP = 16384, TS = 128, TT = TP + TS, MP = 16640;
constexpr int DM = 1024, FF = 2816, NIN = 4864, NINSRC = 4872, DEPTH = 4;
constexpr float EPS = 1e-6f;
constexpr int PC_Q = 0, PC_K = 512, PC_V = 640, PC_RAW = 768, PC_Z = 2304, PC_GA = 2816, PC_GD = 3840;
constexpr size_t O_YP = 0, O_YS = 16777216, O_KP = 16908288, O_VP = 17432576, O_DNP = 17956864, O_CVP = 20054016,
                 O_KS = 20201472, O_VS = 28590080, O_DNS = 36978688, O_CVS = 70533120;
constexpr size_t WL_GU1 = 0, WL_DN1 = WL_GU1 + (size_t)5632 * 1024, WL_WIN = WL_DN1 + (size_t)1024 * 2816, WL_AO = WL_WIN + (size_t)NIN * 1024,
                 WL_DO = WL_AO + (size_t)1024 * 512, WL_WO = WL_DO + (size_t)1024 * 512, WL_GU2 = WL_WO + (size_t)1024 * 1024,
                 WL_DN2 = WL_GU2 + (size_t)5632 * 1024, WL_END = WL_DN2 + (size_t)1024 * 2816;
constexpr size_t MiB = 1u << 20;
constexpr size_t WS_ROPE = 0;
constexpr size_t WS_BG = 1 * MiB;
constexpr size_t WS_GL = 2 * MiB;
constexpr size_t WS_BAR = 2 * MiB + 65536;
constexpr size_t WS_W = 3 * MiB;
constexpr size_t WS_H = WS_W + ((WL_END * 2 * DEPTH + MiB - 1) / MiB) * MiB;
constexpr size_t WS_XN = WS_H + (size_t)MP * DM * 4;
constexpr size_t WS_ACT = WS_XN + (size_t)MP * DM * 2;
constexpr size_t WS_P = WS_ACT + (size_t)MP * FF * 2;
constexpr size_t WS_OA = WS_P + (size_t)MP * NIN * 2;
constexpr size_t WS_OD = WS_OA + (size_t)MP * 512 * 2;
constexpr size_t WS_ODF = WS_OD + (size_t)MP * 512 * 2;
constexpr size_t WS_PART = WS_ODF + (size_t)TP * 512 * 4;
constexpr size_t WS_END = WS_PART + (size_t)11 * TS * DM * 4;
constexpr size_t WS_UT = WS_ACT;
constexpr size_t WS_WN = WS_UT + (size_t)1024 * 8192 * 4;
constexpr size_t WS_QD = WS_WN + (size_t)1024 * 8192 * 2;
constexpr size_t WS_KDT = WS_QD + (size_t)1024 * 8192 * 2;
constexpr size_t WS_QK = WS_KDT + (size_t)1024 * 8192 * 2;
static_assert(WS_QK + (size_t)1024 * 4096 * 2 <= WS_P, "deltanet overlay fits in ACT");
static_assert((size_t)MP * DM * 4 <= (size_t)MP * FF * 2, "TMP fits in ACT");

constexpr int LDS_BYTES = 147456;

struct Params {
    const float* x_prompt; const float* x_sample; const float* cache_k; const float* cache_v; const float* state_dn; const float* state_conv;
    const float* ffn1_norm; const float* ffn1_gu; const float* ffn1_dn; const float* mix_norm; const float* w_in; const float* q_norm; const float* k_norm;
    const float* sinks; const float* conv_w; const float* A_log; const float* dt_bias; const float* dn_out_norm; const float* w_attn_o; const float* w_dn_o;
    const float* w_out; const float* ffn2_norm; const float* ffn2_gu; const float* ffn2_dn;
    float* out; unsigned char* ws;
};

__device__ __forceinline__ unsigned pk2(float lo, float hi);
__device__ __forceinline__ unsigned f2bf(float f) { return pk2(f, 0.f) & 0xffffu; }
typedef float f32x2_t __attribute__((ext_vector_type(2)));
typedef __bf16 bf16x2_t __attribute__((ext_vector_type(2)));
__device__ __forceinline__ unsigned pk2(float lo, float hi) { const f32x2_t v = {lo, hi}; const bf16x2_t b = __builtin_convertvector(v, bf16x2_t); return __builtin_bit_cast(unsigned, b); }
__device__ __forceinline__ float bflo(unsigned w) { return __uint_as_float(w << 16); }
__device__ __forceinline__ float bfhi(unsigned w) { return __uint_as_float(w & 0xffff0000u); }
__device__ __forceinline__ float bf1(bf16_t v) { return __uint_as_float(((unsigned)v) << 16); }
__device__ __forceinline__ float sigmoidf_(float x) { return __builtin_amdgcn_rcpf(1.0f + __expf(-x)); }
__device__ __forceinline__ float siluf_(float x) { return x * __builtin_amdgcn_rcpf(1.0f + __expf(-x)); }
__device__ __forceinline__ float softplusf_(float x) { return x > 20.f ? x : log1pf(__expf(x)); }

namespace pg8 {
constexpr int BM = 256, BK = 64, HALF = 128, HTB = HALF * BK * 2, NXCD = 8, WGM = 8;
__host__ __device__ __forceinline__ int lds_byte(int r, int c) { const int st = (r >> 4) * 2 + (c >> 5), rr = r & 15, cc = c & 31, ob = rr * 64 + cc * 2; return st * 1024 + (ob ^ (((ob >> 9) & 1) << 5)); }
__host__ __device__ __forceinline__ void stage_rc(int b, int& R, int& C) { const int st = b / 1024, sb = b % 1024, swz = sb ^ (((sb >> 9) & 1) << 5); R = (st >> 1) * 16 + swz / 64; C = (st & 1) * 32 + (swz % 64) / 2; }
struct Unit { int pm, pn, k0, nt; };
struct Gemm { const bf16_t* A; const bf16_t* Bt; int M, N, K; };
struct StaticOrder {
    int nM, nN, nwg, G, c, ntMain, extraBase, nExtra, extraNt;
    __device__ void init(int N, int K, int G_, int c_, int extraBase_, int nExtra_, int extraNt_) { nM = 64; nN = N / BM; nwg = nM * nN; G = G_; c = c_; ntMain = K / BK; extraBase = extraBase_; nExtra = nExtra_; extraNt = extraNt_; }
    __device__ bool next(int i, Unit& u) const {
        const long L = (long)i * G + c;
        if (L < nwg) {
            int wgid = (int)L; { const int q = nwg / NXCD, r = nwg % NXCD, xcd = wgid % NXCD, off = wgid / NXCD; wgid = (xcd < r ? xcd * (q + 1) : r * (q + 1) + (xcd - r) * q) + off; }
            const int nig = WGM * nN, gid = wgid / nig, fm = gid * WGM, gsz = (nM - fm) < WGM ? (nM - fm) : WGM;
            u.pm = fm + ((wgid % nig) % gsz); u.pn = (wgid % nig) / gsz; u.k0 = 0; u.nt = ntMain; return true;
        }
        const int nc = (nwg - c + G - 1) / G, j = c - extraBase;
        if (i == nc && j >= 0 && j < nExtra) { u.pm = 64; u.pn = j % nN; u.k0 = (j / nN) * extraNt; u.nt = extraNt; return true; }
        return false;
    }
};
template <class Epi, bool HOOK = false>
__device__ __forceinline__ void gemm_phase(LAS unsigned char* lds, const Gemm g, const StaticOrder& S, const Epi& E, const int tid) {
    const int wid = __builtin_amdgcn_readfirstlane(tid >> 6), lane = tid & 63, wr = wid >> 2, wc = wid & 3, fr = lane & 15, fq = lane >> 4;
    const int K = g.K;
    unsigned voffA[2];
#pragma unroll
    for (int i = 0; i < 2; ++i) { int R, C; stage_rc(tid * 16 + i * 8192, R, C); voffA[i] = (unsigned)(R * K + C) * 2u; }
    const size_t kstep = (size_t)(BK * 2);
    const size_t hstep = (size_t)HALF * K * 2;
    const size_t tstep = 2 * hstep;
    const unsigned ldsw = (unsigned)wid * 1024u;
    const int aoff = lds_byte(wr * 64 + fr, fq * 8), boff = lds_byte(wc * 32 + fr, fq * 8);
#define PG8_SA(b, h) (((b) * 2 + (h)) * HTB)
#define PG8_SB(b, h) ((4 + (b) * 2 + (h)) * HTB)
#define PG8_STAGE(bufoff, gbase) do { _Pragma("unroll") for (int _i = 0; _i < 2; ++_i) \
        __builtin_amdgcn_global_load_lds((const unsigned*)((const char*)(gbase) + voffA[_i]), (LAS unsigned*)(lds + (bufoff) + ldsw + _i * 8192), 16, 0, 0); } while (0)
#define PG8_LDA(dst, b, h) do { _Pragma("unroll") for (int m = 0; m < 4; ++m) _Pragma("unroll") for (int k = 0; k < 2; ++k) dst[m][k] = *(const LAS bf16x8*)(lds + PG8_SA(b, h) + aoff + m * 2048 + k * 1024); } while (0)
#define PG8_LDB(dst, b, h) do { _Pragma("unroll") for (int n = 0; n < 2; ++n) _Pragma("unroll") for (int k = 0; k < 2; ++k) dst[n][k] = *(const LAS bf16x8*)(lds + PG8_SB(b, h) + boff + n * 2048 + k * 1024); } while (0)
#define PG8_MMA(ai, bj, At, Bt) do { __builtin_amdgcn_s_setprio(1); _Pragma("unroll") for (int m = 0; m < 4; ++m) _Pragma("unroll") for (int n = 0; n < 2; ++n) _Pragma("unroll") for (int k = 0; k < 2; ++k) \
        acc[ai][bj][m][n] = __builtin_amdgcn_mfma_f32_16x16x32_bf16(Bt[n][k], At[m][k], acc[ai][bj][m][n], 0, 0, 0); __builtin_amdgcn_s_setprio(0); } while (0)
#define PG8_WAIT_V(n) asm volatile("s_waitcnt vmcnt(" #n ")" ::: "memory")
#define PG8_WAIT_L(n) asm volatile("s_waitcnt lgkmcnt(" #n ")" ::: "memory")
#define PG8_BAR __builtin_amdgcn_s_barrier()
#define PG8_SCHED __builtin_amdgcn_sched_barrier(0)
    Unit cur, nxt; int ui = 0;
    if (!S.next(0, cur)) return;
    f32x4 acc[2][2][4][2];
#pragma unroll
    for (int a = 0; a < 2; ++a)
#pragma unroll
        for (int b = 0; b < 2; ++b)
#pragma unroll
            for (int m = 0; m < 4; ++m)
#pragma unroll
                for (int n = 0; n < 2; ++n) acc[a][b][m][n] = (f32x4){0.f, 0.f, 0.f, 0.f};
    bf16x8 At[4][2], B0[2][2], B1[2][2];
    const char* cA = (const char*)g.A + (size_t)cur.pm * tstep + (size_t)cur.k0 * kstep; const char* cB = (const char*)g.Bt + (size_t)cur.pn * tstep + (size_t)cur.k0 * kstep;
    PG8_STAGE(PG8_SB(0, 0), cB); PG8_STAGE(PG8_SB(0, 1), cB + hstep); PG8_STAGE(PG8_SA(0, 0), cA); PG8_STAGE(PG8_SA(0, 1), cA + hstep);
    if (wr == 1) PG8_BAR;
    PG8_WAIT_V(2); PG8_BAR;
    PG8_STAGE(PG8_SB(1, 0), cB + kstep); PG8_STAGE(PG8_SA(1, 0), cA + kstep); PG8_STAGE(PG8_SB(1, 1), cB + hstep + kstep);
    PG8_WAIT_V(6); PG8_BAR;
    for (;;) {
        const bool has_next = S.next(ui + 1, nxt);
        const char* nA = has_next ? (const char*)g.A + (size_t)nxt.pm * tstep + (size_t)nxt.k0 * kstep : cA; const char* nB = has_next ? (const char*)g.Bt + (size_t)nxt.pn * tstep + (size_t)nxt.k0 * kstep : cB;
        const int nt = cur.nt;
        for (int t = 0; t < nt; t += 2) {
            const bool last = (t == nt - 2);
            if constexpr (HOOK) if (t == 8) { int fr2 = fr, fq2 = fq; asm volatile("" : "+v"(fr2), "+v"(fq2)); E.mid(acc, cur, wr, wc, fr2, fq2); }
            const char* a1 = cA + (size_t)(t + 1) * kstep;
            const char* a2 = last ? nA : cA + (size_t)(t + 2) * kstep; const char* b2 = last ? nB : cB + (size_t)(t + 2) * kstep;
            const char* a3 = a2 + kstep; const char* b3 = b2 + kstep;
            PG8_LDB(B0, 0, 0); PG8_LDB(B1, 0, 1); PG8_SCHED; PG8_LDA(At, 0, 0); PG8_STAGE(PG8_SA(1, 1), a1 + hstep);
            PG8_WAIT_V(8); PG8_WAIT_L(0); PG8_BAR; PG8_MMA(0, 0, At, B0); PG8_MMA(0, 1, At, B1); PG8_BAR; PG8_SCHED;
            PG8_LDA(At, 0, 1); PG8_STAGE(PG8_SB(0, 0), b2); PG8_STAGE(PG8_SB(0, 1), b2 + hstep); PG8_STAGE(PG8_SA(0, 0), a2);
            PG8_WAIT_V(8); PG8_WAIT_L(0); PG8_BAR; PG8_MMA(1, 0, At, B0); PG8_MMA(1, 1, At, B1); PG8_BAR; PG8_SCHED;
            PG8_LDB(B0, 1, 0); PG8_LDB(B1, 1, 1); PG8_SCHED; PG8_LDA(At, 1, 0); PG8_STAGE(PG8_SA(0, 1), a2 + hstep);
            PG8_WAIT_V(8); PG8_WAIT_L(0); PG8_BAR; PG8_MMA(0, 0, At, B0); PG8_MMA(0, 1, At, B1); PG8_BAR; PG8_SCHED;
            PG8_LDA(At, 1, 1); PG8_STAGE(PG8_SB(1, 0), b3); PG8_STAGE(PG8_SB(1, 1), b3 + hstep); PG8_STAGE(PG8_SA(1, 0), a3);
            PG8_WAIT_V(8); PG8_WAIT_L(0); PG8_BAR; PG8_MMA(1, 0, At, B0); PG8_MMA(1, 1, At, B1); PG8_BAR; PG8_SCHED;
        }
        if (wr == 0) PG8_BAR;
        { int fr2 = fr, fq2 = fq; asm volatile("" : "+v"(fr2), "+v"(fq2)); E(acc, cur, wr, wc, fr2, fq2); }
        if (!has_next) break;
#pragma unroll
        for (int a = 0; a < 2; ++a)
#pragma unroll
            for (int b = 0; b < 2; ++b)
#pragma unroll
                for (int m = 0; m < 4; ++m)
#pragma unroll
                    for (int n = 0; n < 2; ++n) acc[a][b][m][n] = (f32x4){0.f, 0.f, 0.f, 0.f};
        cur = nxt; cA = nA; cB = nB; ++ui;
        if (wr == 1) PG8_BAR;
    }
    PG8_WAIT_V(0);
    PG8_BAR;
#undef PG8_SA
#undef PG8_SB
#undef PG8_STAGE
#undef PG8_LDA
#undef PG8_LDB
#undef PG8_MMA
#undef PG8_WAIT_V
#undef PG8_WAIT_L
#undef PG8_BAR
#undef PG8_SCHED
}
}

typedef f32x4 AccT[2][2][4][2];

struct EpiSwiglu {
    bf16_t* act;
    __device__ __forceinline__ void operator()(const AccT& acc, const pg8::Unit& u, int wr, int wc, int fr, int fq) const {
#pragma unroll
        for (int ai = 0; ai < 2; ++ai)
#pragma unroll
            for (int m = 0; m < 4; ++m) {
                const int row = u.pm * 256 + ai * 128 + wr * 64 + m * 16 + fr;
                bf16_t* rp = act + (size_t)row * FF + u.pn * 128 + wc * 32 + fq * 8;
                const f32x4 g0 = acc[ai][0][m][0], u0 = acc[ai][1][m][0], g1 = acc[ai][0][m][1], u1 = acc[ai][1][m][1];
                u32x4 w; w.x = pk2(siluf_(g0[0]) * u0[0], siluf_(g0[1]) * u0[1]); w.y = pk2(siluf_(g0[2]) * u0[2], siluf_(g0[3]) * u0[3]);
                w.z = pk2(siluf_(g1[0]) * u1[0], siluf_(g1[1]) * u1[1]); w.w = pk2(siluf_(g1[2]) * u1[2], siluf_(g1[3]) * u1[3]);
                *(u32x4*)rp = w;
            }
    }
};
struct EpiResid {
    const float* baseP; float* outP; float scale; float* part;
    __device__ __forceinline__ void operator()(const AccT& acc, const pg8::Unit& u, int wr, int wc, int fr, int fq) const {
        if (u.pm == 64) {
            float* pp = part + (size_t)(u.k0 / u.nt) * (TS * DM);
#pragma unroll
            for (int m = 0; m < 4; ++m) {
                const int r = wr * 64 + m * 16 + fr;
#pragma unroll
                for (int bj = 0; bj < 2; ++bj)
#pragma unroll
                    for (int n = 0; n < 2; ++n) *(f32x4*)(pp + (size_t)r * DM + u.pn * 256 + bj * 128 + wc * 32 + fq * 8 + n * 4) = acc[0][bj][m][n];
            }
            return;
        }
#pragma unroll
        for (int ai = 0; ai < 2; ++ai)
#pragma unroll
            for (int m = 0; m < 4; ++m) {
                const int row = u.pm * 256 + ai * 128 + wr * 64 + m * 16 + fr;
                const float* b = baseP + (size_t)row * DM;
                float* o = outP + (size_t)row * DM;
#pragma unroll
                for (int bj = 0; bj < 2; ++bj)
#pragma unroll
                    for (int n = 0; n < 2; ++n) {
                        const int col = u.pn * 256 + bj * 128 + wc * 32 + fq * 8 + n * 4;
                        const f32x4 bv = *(const f32x4*)(b + col);
                        *(f32x4*)(o + col) = bv + scale * acc[ai][bj][m][n];
                    }
            }
    }
};
template <bool SECOND> struct EpiGate {
    const bf16_t* P; float* tmp; bf16_t* mrg;
    __device__ __forceinline__ void operator()(const AccT& acc, const pg8::Unit& u, int wr, int wc, int fr, int fq) const {
#pragma unroll
        for (int ai = 0; ai < 2; ++ai)
#pragma unroll
            for (int m = 0; m < 4; ++m) {
                const int row = u.pm * 256 + ai * 128 + wr * 64 + m * 16 + fr;
                if (row >= TT) continue;
#pragma unroll
                for (int bj = 0; bj < 2; ++bj)
#pragma unroll
                    for (int n = 0; n < 2; ++n) {
                        const int col = u.pn * 256 + bj * 128 + wc * 32 + fq * 8 + n * 4;
                        const u32x2 gw = *(const u32x2*)(P + (size_t)row * NIN + (SECOND ? PC_GD : PC_GA) + col);
                        const f32x4 a = acc[ai][bj][m][n];
                        f32x4 v; v[0] = sigmoidf_(bflo(gw.x)) * a[0]; v[1] = sigmoidf_(bfhi(gw.x)) * a[1]; v[2] = sigmoidf_(bflo(gw.y)) * a[2]; v[3] = sigmoidf_(bfhi(gw.y)) * a[3];
                        float* tp = tmp + (size_t)row * DM + col;
                        if (!SECOND) { *(f32x4*)tp = v; }
                        else { const f32x4 t = *(const f32x4*)tp; v = v + t; u32x2 w; w.x = pk2(v[0], v[1]); w.y = pk2(v[2], v[3]); *(u32x2*)(mrg + (size_t)row * DM + col) = w; }
                    }
            }
    }
};
struct EpiGateK {
    const bf16_t* P; bf16_t* mrg;
    __device__ __forceinline__ void mid(AccT& acc, const pg8::Unit& u, int wr, int wc, int fr, int fq) const {
#pragma unroll
        for (int ai = 0; ai < 2; ++ai)
#pragma unroll
            for (int m = 0; m < 4; ++m) {
                const int row = u.pm * 256 + ai * 128 + wr * 64 + m * 16 + fr;
                if (row >= TT) continue;
#pragma unroll
                for (int bj = 0; bj < 2; ++bj) {
                    const int col = u.pn * 256 + bj * 128 + wc * 32 + fq * 8;
                    const u32x4 ga = *(const u32x4*)(P + (size_t)row * NIN + PC_GA + col), gd = *(const u32x4*)(P + (size_t)row * NIN + PC_GD + col);
                    const unsigned gaw[4] = {ga.x, ga.y, ga.z, ga.w}, gdw[4] = {gd.x, gd.y, gd.z, gd.w};
#pragma unroll
                    for (int q = 0; q < 4; ++q) {
                        const float ea0 = __expf(-bflo(gaw[q])), ea1 = __expf(-bfhi(gaw[q]));
                        const float ed0 = __expf(fminf(-bflo(gdw[q]), 60.f)), ed1 = __expf(fminf(-bfhi(gdw[q]), 60.f));
                        const float r0 = (1.0f + ed0) * __builtin_amdgcn_rcpf(1.0f + ea0), r1 = (1.0f + ed1) * __builtin_amdgcn_rcpf(1.0f + ea1);
                        acc[ai][bj][m][q >> 1][(q & 1) * 2 + 0] *= r0; acc[ai][bj][m][q >> 1][(q & 1) * 2 + 1] *= r1;
                    }
                }
                __builtin_amdgcn_sched_barrier(0);
            }
    }
    __device__ __forceinline__ void operator()(const AccT& acc, const pg8::Unit& u, int wr, int wc, int fr, int fq) const {
#pragma unroll
        for (int ai = 0; ai < 2; ++ai)
#pragma unroll
            for (int m = 0; m < 4; ++m) {
                const int row = u.pm * 256 + ai * 128 + wr * 64 + m * 16 + fr;
                if (row >= TT) continue;
#pragma unroll
                for (int bj = 0; bj < 2; ++bj) {
                    const int col = u.pn * 256 + bj * 128 + wc * 32 + fq * 8;
                    const u32x4 gd = *(const u32x4*)(P + (size_t)row * NIN + PC_GD + col);
                    const unsigned gdw[4] = {gd.x, gd.y, gd.z, gd.w};
                    unsigned ow[4];
#pragma unroll
                    for (int q = 0; q < 4; ++q) {
                        const float s0 = __builtin_amdgcn_rcpf(1.0f + __expf(fminf(-bflo(gdw[q]), 60.f))), s1 = __builtin_amdgcn_rcpf(1.0f + __expf(fminf(-bfhi(gdw[q]), 60.f)));
                        ow[q] = pk2(acc[ai][bj][m][q >> 1][(q & 1) * 2 + 0] * s0, acc[ai][bj][m][q >> 1][(q & 1) * 2 + 1] * s1);
                    }
                    *(u32x4*)(mrg + (size_t)row * DM + col) = (u32x4){ow[0], ow[1], ow[2], ow[3]};
                }
            }
    }
};
struct EpiWin {
    bf16_t* P; const float* qnw; const float* knw; const float2* rope;
    __device__ __forceinline__ void operator()(const AccT& acc, const pg8::Unit& u, int wr, int wc, int fr, int fq) const {
        const int tile = u.pn;
        const bool headed = tile <= 1 || (tile == 2 && wc < 2), isq = tile <= 1;
        const float* nw = isq ? qnw : knw;
        const float sc = isq ? 0.125f : 1.0f;
#pragma unroll
        for (int ai = 0; ai < 2; ++ai)
#pragma unroll
            for (int m = 0; m < 4; ++m) {
                const int row = u.pm * 256 + ai * 128 + wr * 64 + m * 16 + fr;
                const bool valid = row < TT;
                bf16_t* prow = P + (size_t)row * NIN + tile * 256 + wc * 64;
                if (headed) {
                    float ss = 0.f;
#pragma unroll
                    for (int bj = 0; bj < 2; ++bj)
#pragma unroll
                        for (int n = 0; n < 2; ++n) { const f32x4 a = acc[ai][bj][m][n]; ss += a[0] * a[0] + a[1] * a[1] + a[2] * a[2] + a[3] * a[3]; }
                    ss += __shfl_xor(ss, 16); ss += __shfl_xor(ss, 32);
                    if (!valid) continue;
                    const float rs = rsqrtf(ss * (1.0f / 64.0f) + EPS);
                    const float2* rp = rope + (size_t)(row < TP ? (row & 2047) : 2048) * 32;
#pragma unroll
                    for (int n = 0; n < 2; ++n) {
                        const int i0 = fq * 8 + n * 4;
                        const f32x4 w1 = *(const f32x4*)(nw + i0), w2 = *(const f32x4*)(nw + 32 + i0);
                        f32x4 o1, o2;
#pragma unroll
                        for (int j = 0; j < 4; ++j) {
                            const float x1 = acc[ai][0][m][n][j] * rs * w1[j], x2 = acc[ai][1][m][n][j] * rs * w2[j];
                            const float2 cs = rp[i0 + j];
                            o1[j] = (x1 * cs.x - x2 * cs.y) * sc; o2[j] = (x2 * cs.x + x1 * cs.y) * sc;
                        }
                        u32x2 a, b; a.x = pk2(o1[0], o1[1]); a.y = pk2(o1[2], o1[3]); b.x = pk2(o2[0], o2[1]); b.y = pk2(o2[2], o2[3]);
                        *(u32x2*)(prow + i0) = a; *(u32x2*)(prow + 32 + i0) = b;
                    }
                } else {
                    if (!valid) continue;
#pragma unroll
                    for (int bj = 0; bj < 2; ++bj)
#pragma unroll
                        for (int n = 0; n < 2; ++n) {
                            const f32x4 a = acc[ai][bj][m][n];
                            u32x2 w; w.x = pk2(a[0], a[1]); w.y = pk2(a[2], a[3]);
                            *(u32x2*)(prow + bj * 32 + fq * 8 + n * 4) = w;
                        }
                }
            }
    }
};

typedef const __attribute__((address_space(4))) Params* PK;
struct Ctx { LAS unsigned char* lds; int tid, lane, wave, G, bid; };

__device__ __forceinline__ int src_col(int type, int n0) {
    if (type == 0) return n0;
    const int tile = n0 >> 8, p = n0 & 255;
    if (type == 1) return p < 128 ? tile * 128 + p : FF + tile * 128 + (p - 128);
    const int bj = p >> 7, wc = (p >> 5) & 3, c32 = p & 31; const int lg = tile * 256 + wc * 64 + bj * 32 + c32;
    return lg < PC_GA ? lg : lg + 8;
}
__device__ __forceinline__ void convert_weight(const Ctx& C, const float* src, int ld, int K, int N, int type, bf16_t* dst, int dld = 0, int koff = 0) {
    if (dld == 0) dld = K;
    LAS float* tile = (LAS float*)C.lds;
    const int nnt = N / 32, nitems = nnt * (K / 256);
    for (int it = C.bid; it < nitems; it += C.G) {
        const int ntile = it % nnt, kt = it / nnt, n0 = ntile * 32, k0 = kt * 256, s0 = src_col(type, n0);
        const int c4 = (C.tid & 7) * 4, kr = C.tid >> 3;
        f32x4 v[4];
#pragma unroll
        for (int p = 0; p < 4; ++p) v[p] = __builtin_nontemporal_load((const f32x4*)(src + (size_t)(k0 + p * 64 + kr) * ld + s0 + c4));
#pragma unroll
        for (int p = 0; p < 4; ++p) { LAS float* tp = tile + (p * 64 + kr) * 33 + c4; tp[0] = v[p][0]; tp[1] = v[p][1]; tp[2] = v[p][2]; tp[3] = v[p][3]; }
        __syncthreads();
#pragma unroll
        for (int h2 = 0; h2 < 2; ++h2) {
            const int n = C.tid >> 4, ks = (C.tid & 15) * 8 + h2 * 128;
            const int ln = 8 * ((n >> 2) & 3) + 4 * (n >> 4) + (n & 3);
            u32x4 w;
            w.x = pk2(tile[(ks + 0) * 33 + ln], tile[(ks + 1) * 33 + ln]); w.y = pk2(tile[(ks + 2) * 33 + ln], tile[(ks + 3) * 33 + ln]);
            w.z = pk2(tile[(ks + 4) * 33 + ln], tile[(ks + 5) * 33 + ln]); w.w = pk2(tile[(ks + 6) * 33 + ln], tile[(ks + 7) * 33 + ln]);
            *(u32x4*)(dst + (size_t)(n0 + n) * dld + koff + k0 + ks) = w;
        }
        __syncthreads();
    }
}

__device__ __forceinline__ float wave_sum(float v) {
#pragma unroll
    for (int o = 1; o < 64; o <<= 1) v += __shfl_xor(v, o);
    return v;
}

template <bool WITH_BG>
__device__ __forceinline__ void norm_phase(const Ctx& C, const float* inP, const float* inS, const float* w, bf16_t* xn, const float* win_l, float* bg, const float* part, int np, float pscale, float* soutS) {
    float wb[16][8];
    if (WITH_BG) {
#pragma unroll
        for (int c = 0; c < 4; ++c)
#pragma unroll
            for (int e = 0; e < 4; ++e) {
                const float* wp = win_l + (size_t)(c * 256 + C.lane * 4 + e) * NINSRC + 2816;
                const f32x4 a = *(const f32x4*)wp, b = *(const f32x4*)(wp + 4);
                wb[c * 4 + e][0] = a[0]; wb[c * 4 + e][1] = a[1]; wb[c * 4 + e][2] = a[2]; wb[c * 4 + e][3] = a[3];
                wb[c * 4 + e][4] = b[0]; wb[c * 4 + e][5] = b[1]; wb[c * 4 + e][6] = b[2]; wb[c * 4 + e][7] = b[3];
            }
    }
    f32x4 nv[4];
    { const int row = C.bid * 8 + C.wave;
      if (row < TT) { const float* x = row < TP ? inP + (size_t)row * DM : inS + (size_t)(row - TP) * DM;
#pragma unroll
        for (int c = 0; c < 4; ++c) nv[c] = *(const f32x4*)(x + c * 256 + C.lane * 4); } }
    for (int row = C.bid * 8 + C.wave; row < TT; row += C.G * 8) {
        f32x4 v[4]; float ss = 0.f;
#pragma unroll
        for (int c = 0; c < 4; ++c) v[c] = nv[c];
        { const int r2 = row + C.G * 8;
          if (r2 < TT) { const float* x2 = r2 < TP ? inP + (size_t)r2 * DM : inS + (size_t)(r2 - TP) * DM;
#pragma unroll
            for (int c = 0; c < 4; ++c) nv[c] = *(const f32x4*)(x2 + c * 256 + C.lane * 4); } }
        if (row >= TP && np > 0) {
            f32x4 a[4];
#pragma unroll
            for (int c = 0; c < 4; ++c) a[c] = (f32x4){0.f, 0.f, 0.f, 0.f};
            for (int i = 0; i < np; ++i) {
                const float* pp = part + ((size_t)i * TS + (row - TP)) * DM + C.lane * 4;
#pragma unroll
                for (int c = 0; c < 4; ++c) a[c] += *(const f32x4*)(pp + c * 256);
            }
#pragma unroll
            for (int c = 0; c < 4; ++c) { v[c] += pscale * a[c]; *(f32x4*)(soutS + (size_t)(row - TP) * DM + c * 256 + C.lane * 4) = v[c]; }
        }
#pragma unroll
        for (int c = 0; c < 4; ++c) ss += v[c][0] * v[c][0] + v[c][1] * v[c][1] + v[c][2] * v[c][2] + v[c][3] * v[c][3];
        ss = wave_sum(ss);
        const float rs = rsqrtf(ss * (1.0f / 1024.0f) + EPS);
        float d[8];
        if (WITH_BG) {
#pragma unroll
            for (int q = 0; q < 8; ++q) d[q] = 0.f;
        }
#pragma unroll
        for (int c = 0; c < 4; ++c) {
            const f32x4 wv = *(const f32x4*)(w + c * 256 + C.lane * 4);
            f32x4 y = v[c] * rs * wv;
            u32x2 o; o.x = pk2(y[0], y[1]); o.y = pk2(y[2], y[3]);
            *(u32x2*)(xn + (size_t)row * DM + c * 256 + C.lane * 4) = o;
            if (WITH_BG) {
#pragma unroll
                for (int e = 0; e < 4; ++e)
#pragma unroll
                    for (int q = 0; q < 8; ++q) d[q] += y[e] * wb[c * 4 + e][q];
            }
        }
        if (WITH_BG) {
#pragma unroll
            for (int q = 0; q < 8; ++q) d[q] = wave_sum(d[q]);
            if (C.lane == 0) { *(f32x4*)(bg + (size_t)row * 8) = (f32x4){d[0], d[1], d[2], d[3]}; *(f32x4*)(bg + (size_t)row * 8 + 4) = (f32x4){d[4], d[5], d[6], d[7]}; }
        }
    }
}

__device__ __forceinline__ void finalize_od(const Ctx& C, const float* odf, const bf16_t* P, const float* onw, bf16_t* od) {
    const int e0 = (C.lane & 15) * 8;
    const f32x4 w0 = *(const f32x4*)(onw + e0), w1 = *(const f32x4*)(onw + e0 + 4);
    f32x4 na, nb; u32x4 nz;
    { const int row = C.bid * 8 + C.wave;
      if (row < TP) { const float* op = odf + (size_t)row * 512 + C.lane * 8; na = *(const f32x4*)op; nb = *(const f32x4*)(op + 4); nz = *(const u32x4*)(P + (size_t)row * NIN + PC_Z + C.lane * 8); } }
    for (int row = C.bid * 8 + C.wave; row < TP; row += C.G * 8) {
        const f32x4 a = na, b = nb; const u32x4 z = nz;
        { const int r2 = row + C.G * 8;
          if (r2 < TP) { const float* op = odf + (size_t)r2 * 512 + C.lane * 8; na = *(const f32x4*)op; nb = *(const f32x4*)(op + 4); nz = *(const u32x4*)(P + (size_t)r2 * NIN + PC_Z + C.lane * 8); } }
        float ss = a[0] * a[0] + a[1] * a[1] + a[2] * a[2] + a[3] * a[3] + b[0] * b[0] + b[1] * b[1] + b[2] * b[2] + b[3] * b[3];
        ss += __shfl_xor(ss, 1); ss += __shfl_xor(ss, 2); ss += __shfl_xor(ss, 4); ss += __shfl_xor(ss, 8);
        const float rs = rsqrtf(ss * (1.0f / 128.0f) + EPS);
        u32x4 o;
        o.x = pk2(a[0] * rs * w0[0] * siluf_(bflo(z.x)), a[1] * rs * w0[1] * siluf_(bfhi(z.x)));
        o.y = pk2(a[2] * rs * w0[2] * siluf_(bflo(z.y)), a[3] * rs * w0[3] * siluf_(bfhi(z.y)));
        o.z = pk2(b[0] * rs * w1[0] * siluf_(bflo(z.z)), b[1] * rs * w1[1] * siluf_(bfhi(z.z)));
        o.w = pk2(b[2] * rs * w1[2] * siluf_(bflo(z.w)), b[3] * rs * w1[3] * siluf_(bfhi(z.w)));
        *(u32x4*)(od + (size_t)row * 1024 + 512 + C.lane * 8) = o;
    }
}

__device__ __forceinline__ void attn_prompt_unit(const Ctx& C, int unit, const bf16_t* P, const float* sinks_l, bf16_t* OA) {
    const int kvh = unit & 1, qb = (unit >> 1) & 15, b = unit >> 5;
    LAS unsigned char* Ks = C.lds;
    LAS unsigned char* Vt = C.lds + 36864;
    const int tok0 = b * 2048 + qb * 128 - 128;
    bf16x8 qfa[2][2][2];
    {
        const int g_ = C.wave >> 1, hq_ = C.wave & 1, h_ = kvh * 4 + g_, fr_ = C.lane & 15, fq_ = C.lane >> 4;
#pragma unroll
        for (int it = 0; it < 2; ++it)
#pragma unroll
            for (int qt = 0; qt < 2; ++qt)
#pragma unroll
                for (int kk = 0; kk < 2; ++kk)
                    qfa[it][qt][kk] = *(const bf16x8*)(P + (size_t)(b * 2048 + qb * 128 + hq_ * 64 + it * 32 + qt * 16 + fr_) * NIN + PC_Q + h_ * 64 + kk * 32 + fq_ * 8);
    }
#pragma unroll
    for (int p = 0; p < 4; ++p) {
        const int id = C.tid + p * 512, r = id >> 3, ch = id & 7;
        const bool ok = (qb > 0) || (r >= 128);
        u32x4 kv = (u32x4){0u, 0u, 0u, 0u}, vv = (u32x4){0u, 0u, 0u, 0u};
        if (ok) { const bf16_t* rp = P + (size_t)(tok0 + r) * NIN; kv = *(const u32x4*)(rp + PC_K + kvh * 64 + ch * 8); vv = *(const u32x4*)(rp + PC_V + kvh * 64 + ch * 8); }
        *(LAS u32x4*)(Ks + r * 144 + ch * 16) = kv;
        LAS bf16_t* vt = (LAS bf16_t*)(Vt + (ch * 8) * 528 + r * 2);
        vt[0 * 264] = (bf16_t)(vv.x & 0xffff); vt[1 * 264] = (bf16_t)(vv.x >> 16); vt[2 * 264] = (bf16_t)(vv.y & 0xffff); vt[3 * 264] = (bf16_t)(vv.y >> 16);
        vt[4 * 264] = (bf16_t)(vv.z & 0xffff); vt[5 * 264] = (bf16_t)(vv.z >> 16); vt[6 * 264] = (bf16_t)(vv.w & 0xffff); vt[7 * 264] = (bf16_t)(vv.w >> 16);
    }
    __syncthreads();
    const int g = C.wave >> 1, hq = C.wave & 1, h = kvh * 4 + g, fr = C.lane & 15, fq = C.lane >> 4;
    const float sink = sinks_l[h];
#pragma unroll 1
    for (int it = 0; it < 2; ++it) {
        const int tq0 = hq * 64 + it * 32, jb0 = tq0;
        bf16x8 qf[2][2];
#pragma unroll
        for (int qt = 0; qt < 2; ++qt)
#pragma unroll
            for (int kk = 0; kk < 2; ++kk) qf[qt][kk] = it == 0 ? qfa[0][qt][kk] : qfa[1][qt][kk];
        f32x4 st[2][10];
#pragma unroll
        for (int kt = 0; kt < 10; ++kt) {
            st[0][kt] = (f32x4){0.f, 0.f, 0.f, 0.f}; st[1][kt] = (f32x4){0.f, 0.f, 0.f, 0.f};
#pragma unroll
            for (int kk = 0; kk < 2; ++kk) {
                const bf16x8 kf = *(const LAS bf16x8*)(Ks + (jb0 + kt * 16 + fr) * 144 + (kk * 32 + fq * 8) * 2);
                st[0][kt] = __builtin_amdgcn_mfma_f32_16x16x32_bf16(kf, qf[0][kk], st[0][kt], 0, 0, 0);
                st[1][kt] = __builtin_amdgcn_mfma_f32_16x16x32_bf16(kf, qf[1][kk], st[1][kt], 0, 0, 0);
            }
        }
        bf16x8 pb[2][5]; float linv[2];
#pragma unroll
        for (int qt = 0; qt < 2; ++qt) {
            const int tq = tq0 + qt * 16 + fr;
            float mx = sink;
#pragma unroll
            for (int kt = 0; kt < 10; ++kt)
#pragma unroll
                for (int j = 0; j < 4; ++j) {
                    const int jb = jb0 + kt * 16 + fq * 4 + j, rel = 128 + tq - jb;
                    const bool ok = rel >= 0 && rel <= 128 && (qb > 0 || jb >= 128);
                    const float s = ok ? st[qt][kt][j] : -INFINITY;
                    st[qt][kt][j] = s; mx = fmaxf(mx, s);
                }
            mx = fmaxf(mx, __shfl_xor(mx, 16)); mx = fmaxf(mx, __shfl_xor(mx, 32));
            float l = 0.f;
#pragma unroll
            for (int kt = 0; kt < 10; ++kt)
#pragma unroll
                for (int j = 0; j < 4; ++j) { const float p = __expf(st[qt][kt][j] - mx); st[qt][kt][j] = p; l += p; }
            l += __shfl_xor(l, 16); l += __shfl_xor(l, 32);
            l += __expf(sink - mx);
            linv[qt] = 1.0f / l;
#pragma unroll
            for (int sl = 0; sl < 5; ++sl) {
                const f32x4 p0 = st[qt][2 * sl], p1 = st[qt][2 * sl + 1];
                u32x4 w; w.x = pk2(p0[0], p0[1]); w.y = pk2(p0[2], p0[3]); w.z = pk2(p1[0], p1[1]); w.w = pk2(p1[2], p1[3]);
                pb[qt][sl] = __builtin_bit_cast(bf16x8, w);
            }
        }
        f32x4 ot[2][4];
#pragma unroll
        for (int dt = 0; dt < 4; ++dt) { ot[0][dt] = (f32x4){0.f, 0.f, 0.f, 0.f}; ot[1][dt] = (f32x4){0.f, 0.f, 0.f, 0.f}; }
#pragma unroll
        for (int sl = 0; sl < 5; ++sl)
#pragma unroll
            for (int dt = 0; dt < 4; ++dt) {
                const LAS unsigned char* vp = Vt + (dt * 16 + fr) * 528 + (jb0 + sl * 32 + fq * 4) * 2;
                const u32x2 v0 = *(const LAS u32x2*)vp, v1 = *(const LAS u32x2*)(vp + 32);
                const u32x4 vw = (u32x4){v0.x, v0.y, v1.x, v1.y};
                const bf16x8 vf = __builtin_bit_cast(bf16x8, vw);
                ot[0][dt] = __builtin_amdgcn_mfma_f32_16x16x32_bf16(vf, pb[0][sl], ot[0][dt], 0, 0, 0);
                ot[1][dt] = __builtin_amdgcn_mfma_f32_16x16x32_bf16(vf, pb[1][sl], ot[1][dt], 0, 0, 0);
            }
#pragma unroll
        for (int qt = 0; qt < 2; ++qt) {
            bf16_t* op = OA + (size_t)(b * 2048 + qb * 128 + tq0 + qt * 16 + fr) * 1024 + h * 64 + fq * 4;
#pragma unroll
            for (int dt = 0; dt < 4; ++dt) {
                const f32x4 o = ot[qt][dt] * linv[qt];
                u32x2 w; w.x = pk2(o[0], o[1]); w.y = pk2(o[2], o[3]);
                *(u32x2*)(op + dt * 16) = w;
            }
        }
    }
    __syncthreads();
}

__device__ __forceinline__ void attn_sample_task(const Ctx& C, int task, int l, PK p, const bf16_t* P, bf16_t* OA) {
    const int b = task >> 3, h = task & 7, kvh = h >> 2, lane = C.lane;
    const size_t row = (size_t)TP + b;
    const float* ck = p->cache_k + ((size_t)(l * 128 + b) * 128) * 128 + kvh * 64;
    const float* cv = p->cache_v + ((size_t)(l * 128 + b) * 128) * 128 + kvh * 64;
    u32x4 qw[8];
#pragma unroll
    for (int i = 0; i < 8; ++i) qw[i] = *(const u32x4*)(P + row * NIN + PC_Q + h * 64 + i * 8);
    float s0 = 0.f, s1 = 0.f, s2 = 0.f;
    {
        const float* k0 = ck + (size_t)lane * 128; const float* k1 = ck + (size_t)(lane + 64) * 128;
#pragma unroll
        for (int i = 0; i < 8; ++i) {
            const f32x4 a0 = *(const f32x4*)(k0 + i * 8), a1 = *(const f32x4*)(k0 + i * 8 + 4), b0 = *(const f32x4*)(k1 + i * 8), b1 = *(const f32x4*)(k1 + i * 8 + 4);
            const float q0 = bflo(qw[i].x), q1 = bfhi(qw[i].x), q2 = bflo(qw[i].y), q3 = bfhi(qw[i].y), q4 = bflo(qw[i].z), q5 = bfhi(qw[i].z), q6 = bflo(qw[i].w), q7 = bfhi(qw[i].w);
            s0 += q0 * a0[0] + q1 * a0[1] + q2 * a0[2] + q3 * a0[3] + q4 * a1[0] + q5 * a1[1] + q6 * a1[2] + q7 * a1[3];
            s1 += q0 * b0[0] + q1 * b0[1] + q2 * b0[2] + q3 * b0[3] + q4 * b1[0] + q5 * b1[1] + q6 * b1[2] + q7 * b1[3];
            const u32x4 kn = *(const u32x4*)(P + row * NIN + PC_K + kvh * 64 + i * 8);
            s2 += q0 * bflo(kn.x) + q1 * bfhi(kn.x) + q2 * bflo(kn.y) + q3 * bfhi(kn.y) + q4 * bflo(kn.z) + q5 * bfhi(kn.z) + q6 * bflo(kn.w) + q7 * bfhi(kn.w);
        }
    }
    const float sink = p->sinks[l * 8 + h];
    float mx = fmaxf(fmaxf(s0, s1), fmaxf(s2, sink));
#pragma unroll
    for (int o = 1; o < 64; o <<= 1) mx = fmaxf(mx, __shfl_xor(mx, o));
    const float p0 = __expf(s0 - mx), p1 = __expf(s1 - mx), p2 = __expf(s2 - mx);
    const float lsum = wave_sum(p0 + p1) + p2 + __expf(sink - mx);
    float o = p2 * bf1(P[row * NIN + PC_V + kvh * 64 + lane]);
    for (int j = 0; j < 64; ++j) {
        const float pa = __shfl(p0, j), pbv = __shfl(p1, j);
        o += pa * cv[(size_t)j * 128 + lane] + pbv * cv[(size_t)(j + 64) * 128 + lane];
    }
    OA[row * 1024 + h * 64 + lane] = (bf16_t)f2bf(o / lsum);
    if ((h & 3) == 0) {
        float* ok = p->out + O_KS + ((size_t)(l * 128 + b) * 128) * 128 + kvh * 64;
        float* ov = p->out + O_VS + ((size_t)(l * 128 + b) * 128) * 128 + kvh * 64;
        for (int j = 0; j < 127; ++j) { __builtin_nontemporal_store(ck[(size_t)(j + 1) * 128 + lane], ok + (size_t)j * 128 + lane); __builtin_nontemporal_store(cv[(size_t)(j + 1) * 128 + lane], ov + (size_t)j * 128 + lane); }
        ok[(size_t)127 * 128 + lane] = bf1(P[row * NIN + PC_K + kvh * 64 + lane]); ov[(size_t)127 * 128 + lane] = bf1(P[row * NIN + PC_V + kvh * 64 + lane]);
    }
}

__device__ __forceinline__ void dn_sample_task(const Ctx& C, int task, int l, PK p, const bf16_t* P, const float* BG, bf16_t* OD) {
    const int b = task >> 2, h = task & 3, tid = C.tid;
    const size_t row = (size_t)TP + b;
    LAS float* sq = (LAS float*)C.lds;
    LAS float* red = sq + 384;
    LAS float* scal = red + 512;
    const float* sc = p->state_conv + (size_t)(l * 128 + b) * 3 * 1536;
    float s[32];
    {
        const float* S0h = p->state_dn + ((size_t)(l * 128 + b) * 4 + h) * 16384 + (size_t)(tid >> 7) * 32 * 128 + (tid & 127);
#pragma unroll
        for (int dd = 0; dd < 32; ++dd) s[dd] = __builtin_nontemporal_load(S0h + (size_t)dd * 128);
    }
    if (tid < 384) {
        const int which = tid >> 7, ch = tid & 127, c = which * 512 + h * 128 + ch;
        const float* cw = p->conv_w + (size_t)l * 4 * 1536 + c;
        const float x0 = sc[c], x1 = sc[1536 + c], x2 = sc[3072 + c], x3 = bf1(P[row * NIN + PC_RAW + c]);
        const float y = x0 * cw[0] + x1 * cw[1536] + x2 * cw[3072] + x3 * cw[4608];
        sq[which * 128 + ch] = siluf_(y);
        float* oc = p->out + O_CVS + (size_t)(l * 128 + b) * 3 * 1536;
        oc[c] = x1; oc[1536 + c] = x2; oc[3072 + c] = x3;
    }
    __syncthreads();
    if (C.wave < 2) {
        const float a = sq[C.wave * 128 + C.lane], bq = sq[C.wave * 128 + 64 + C.lane];
        const float ssum = wave_sum(a * a + bq * bq);
        if (C.lane == 0) scal[C.wave] = rsqrtf(ssum + EPS);
    }
    __syncthreads();
    const float qsc = scal[0] * 0.08838834764831845f, ksc = scal[1];
    const float beta = sigmoidf_(BG[row * 8 + h]);
    const float gdec = __expf(-__expf(p->A_log[l * 4 + h]) * softplusf_(BG[row * 8 + 4 + h] + p->dt_bias[l * 4 + h]));
    const int e = tid & 127, dq = tid >> 7;
    const float* S0 = p->state_dn + ((size_t)(l * 128 + b) * 4 + h) * 16384;
    float* So = p->out + O_DNS + ((size_t)(l * 128 + b) * 4 + h) * 16384;
    float pred = 0.f;
#pragma unroll
    for (int dd = 0; dd < 32; ++dd) { const int d = dq * 32 + dd; s[dd] *= gdec; pred += sq[128 + d] * ksc * s[dd]; }
    red[dq * 128 + e] = pred;
    __syncthreads();
    const float predt = red[e] + red[128 + e] + red[256 + e] + red[384 + e];
    const float delta = beta * (sq[256 + e] - predt);
    float o = 0.f;
#pragma unroll
    for (int dd = 0; dd < 32; ++dd) { const int d = dq * 32 + dd; s[dd] += sq[128 + d] * ksc * delta; __builtin_nontemporal_store(s[dd], So + (size_t)d * 128 + e); o += sq[d] * qsc * s[dd]; }
    __syncthreads();
    red[dq * 128 + e] = o;
    __syncthreads();
    if (tid < 128) {
        const float ot = red[e] + red[128 + e] + red[256 + e] + red[384 + e];
        const float ssum = wave_sum(ot * ot);
        if (C.lane == 0) scal[2 + C.wave] = ssum;
        sq[e] = ot;
    }
    __syncthreads();
    if (tid < 128) {
        const float rs = rsqrtf((scal[2] + scal[3]) * (1.0f / 128.0f) + EPS);
        const float z = bf1(P[row * NIN + PC_Z + h * 128 + e]);
        OD[row * 1024 + 512 + h * 128 + e] = (bf16_t)f2bf(sq[e] * rs * p->dn_out_norm[l * 128 + e] * siluf_(z));
    }
    __syncthreads();
}

__device__ __forceinline__ void dn_pre_unit(const Ctx& C, int unit, int l, PK p, const bf16_t* P, const float* BG) {
    const int h = unit & 3, n = (unit >> 2) & 31, b = unit >> 7;
    const int tid = C.tid, lane = C.lane, w = C.wave, fr = lane & 15, fq = lane >> 4;
    LAS unsigned char* Ks = C.lds;
    LAS unsigned char* Qs = C.lds + 17408;
    LAS unsigned char* Vt = C.lds + 34816;
    LAS unsigned char* KtW = C.lds + 53248;
    LAS unsigned char* KdT = C.lds + 71680;
    LAS float* A2 = (LAS float*)(C.lds + 90112);
    LAS unsigned char* Ts = C.lds + 106496;
    LAS float* sG = (LAS float*)(C.lds + 115712);
    LAS float* sB = sG + 64;
    unsigned char* ws = p->ws;
    float* UT = (float*)(ws + WS_UT) + (size_t)unit * 8192;
    bf16_t* WN = (bf16_t*)(ws + WS_WN) + (size_t)unit * 8192;
    bf16_t* QD = (bf16_t*)(ws + WS_QD) + (size_t)unit * 8192;
    bf16_t* KDT = (bf16_t*)(ws + WS_KDT) + (size_t)unit * 8192;
    bf16_t* QK = (bf16_t*)(ws + WS_QK) + (size_t)unit * 4096;
    const int row0 = b * 2048 + n * 64;
    u32x4 pre[2][4][2];
    {
        const int t = tid >> 3, ch0 = (tid & 7) * 16;
#pragma unroll
        for (int which = 0; which < 2; ++which)
#pragma unroll
            for (int i = 0; i < 4; ++i) {
                const int tt = n * 64 + t - 3 + i;
                pre[which][i][0] = (u32x4){0u, 0u, 0u, 0u}; pre[which][i][1] = (u32x4){0u, 0u, 0u, 0u};
                if (tt >= 0) { const bf16_t* rp = P + (size_t)(b * 2048 + tt) * NIN + PC_RAW + which * 512 + h * 128 + ch0; pre[which][i][0] = *(const u32x4*)rp; pre[which][i][1] = *(const u32x4*)(rp + 8); }
            }
    }
    if (w == 0) {
        const float bb = BG[(size_t)(row0 + lane) * 8 + h], aa = BG[(size_t)(row0 + lane) * 8 + 4 + h];
        const float beta = sigmoidf_(bb);
        float gsum = -__expf(p->A_log[l * 4 + h]) * softplusf_(aa + p->dt_bias[l * 4 + h]);
#pragma unroll
        for (int o = 1; o < 64; o <<= 1) { const float t = __shfl_up(gsum, o); if (lane >= o) gsum += t; }
        sG[lane] = gsum; sB[lane] = beta;
        if (lane == 63) ((float*)(ws + WS_GL))[unit] = __expf(gsum);
    }
    __syncthreads();
    for (int r2_ = 0; r2_ < 1 + ((SUBREP >> 8) & 1); ++r2_)
    {
        const int t = tid >> 3, ch0 = (tid & 7) * 16;
        const float Gt = sG[t], bt = sB[t], eG = __expf(Gt), eGl = __expf(sG[63] - Gt);
#pragma unroll
        for (int which = 0; which < 3; ++which) {
            const int c = which * 512 + h * 128 + ch0;
            float y[16];
#pragma unroll
            for (int q = 0; q < 16; ++q) y[q] = 0.f;
#pragma unroll
            for (int i = 0; i < 4; ++i) {
                const int tt = n * 64 + t - 3 + i;
                if (tt >= 0) {
                    u32x4 x0, x1;
                    if (which < 2) { x0 = pre[which < 2 ? which : 0][i][0]; x1 = pre[which < 2 ? which : 0][i][1]; }
                    else { const bf16_t* rp = P + (size_t)(b * 2048 + tt) * NIN + PC_RAW + c; x0 = *(const u32x4*)rp; x1 = *(const u32x4*)(rp + 8); }
                    const float* cw = p->conv_w + ((size_t)l * 4 + i) * 1536 + c;
                    const f32x4 w0 = *(const f32x4*)cw, w1 = *(const f32x4*)(cw + 4), w2 = *(const f32x4*)(cw + 8), w3 = *(const f32x4*)(cw + 12);
                    y[0] += bflo(x0.x) * w0[0]; y[1] += bfhi(x0.x) * w0[1]; y[2] += bflo(x0.y) * w0[2]; y[3] += bfhi(x0.y) * w0[3];
                    y[4] += bflo(x0.z) * w1[0]; y[5] += bfhi(x0.z) * w1[1]; y[6] += bflo(x0.w) * w1[2]; y[7] += bfhi(x0.w) * w1[3];
                    y[8] += bflo(x1.x) * w2[0]; y[9] += bfhi(x1.x) * w2[1]; y[10] += bflo(x1.y) * w2[2]; y[11] += bfhi(x1.y) * w2[3];
                    y[12] += bflo(x1.z) * w3[0]; y[13] += bfhi(x1.z) * w3[1]; y[14] += bflo(x1.w) * w3[2]; y[15] += bfhi(x1.w) * w3[3];
                }
            }
            float ss = 0.f;
#pragma unroll
            for (int q = 0; q < 16; ++q) { y[q] = siluf_(y[q]); ss += y[q] * y[q]; }
            if (which < 2) { ss += __shfl_xor(ss, 1); ss += __shfl_xor(ss, 2); ss += __shfl_xor(ss, 4); }
            if (which == 0) {
                const float sc = rsqrtf(ss + EPS) * 0.08838834764831845f;
                u32x4 a, d2, qa, qb2;
                a.x = pk2(y[0] * sc, y[1] * sc); a.y = pk2(y[2] * sc, y[3] * sc); a.z = pk2(y[4] * sc, y[5] * sc); a.w = pk2(y[6] * sc, y[7] * sc);
                d2.x = pk2(y[8] * sc, y[9] * sc); d2.y = pk2(y[10] * sc, y[11] * sc); d2.z = pk2(y[12] * sc, y[13] * sc); d2.w = pk2(y[14] * sc, y[15] * sc);
                *(LAS u32x4*)(Qs + t * 272 + ch0 * 2) = a; *(LAS u32x4*)(Qs + t * 272 + ch0 * 2 + 16) = d2;
                const float s2 = sc * eG;
                qa.x = pk2(y[0] * s2, y[1] * s2); qa.y = pk2(y[2] * s2, y[3] * s2); qa.z = pk2(y[4] * s2, y[5] * s2); qa.w = pk2(y[6] * s2, y[7] * s2);
                qb2.x = pk2(y[8] * s2, y[9] * s2); qb2.y = pk2(y[10] * s2, y[11] * s2); qb2.z = pk2(y[12] * s2, y[13] * s2); qb2.w = pk2(y[14] * s2, y[15] * s2);
                *(u32x4*)(QD + t * 128 + ch0) = qa; *(u32x4*)(QD + t * 128 + ch0 + 8) = qb2;
            } else if (which == 1) {
                const float sc = rsqrtf(ss + EPS);
                u32x4 a, d2;
                a.x = pk2(y[0] * sc, y[1] * sc); a.y = pk2(y[2] * sc, y[3] * sc); a.z = pk2(y[4] * sc, y[5] * sc); a.w = pk2(y[6] * sc, y[7] * sc);
                d2.x = pk2(y[8] * sc, y[9] * sc); d2.y = pk2(y[10] * sc, y[11] * sc); d2.z = pk2(y[12] * sc, y[13] * sc); d2.w = pk2(y[14] * sc, y[15] * sc);
                *(LAS u32x4*)(Ks + t * 272 + ch0 * 2) = a; *(LAS u32x4*)(Ks + t * 272 + ch0 * 2 + 16) = d2;
                const float s1 = sc * bt * eG, s3 = sc * eGl;
#pragma unroll
                for (int q = 0; q < 16; ++q) {
                    *(LAS bf16_t*)(KtW + (ch0 + q) * 144 + t * 2) = (bf16_t)f2bf(y[q] * s1);
                    *(LAS bf16_t*)(KdT + (ch0 + q) * 144 + t * 2) = (bf16_t)f2bf(y[q] * s3);
                }
            } else {
#pragma unroll
                for (int q = 0; q < 16; ++q) *(LAS bf16_t*)(Vt + (ch0 + q) * 144 + t * 2) = (bf16_t)f2bf(y[q] * bt);
            }
        }
    }
    __syncthreads();
    {
        const int itile = w & 3; const bool isq = w >= 4;
        LAS unsigned char* Arows = isq ? Qs : Ks;
        bf16x8 af[4];
#pragma unroll
        for (int k4 = 0; k4 < 4; ++k4) af[k4] = *(const LAS bf16x8*)(Arows + (itile * 16 + fr) * 272 + (k4 * 32 + fq * 8) * 2);
#pragma unroll
        for (int jt = 0; jt < 4; ++jt) {
            f32x4 acc = (f32x4){0.f, 0.f, 0.f, 0.f};
#pragma unroll
            for (int k4 = 0; k4 < 4; ++k4) {
                const bf16x8 bfv = *(const LAS bf16x8*)(Ks + (jt * 16 + fr) * 272 + (k4 * 32 + fq * 8) * 2);
                acc = __builtin_amdgcn_mfma_f32_16x16x32_bf16(af[k4], bfv, acc, 0, 0, 0);
            }
            const int j = jt * 16 + fr; const float Gj = sG[j];
#pragma unroll
            for (int jj = 0; jj < 4; ++jj) {
                const int i = itile * 16 + fq * 4 + jj;
                const float dec = __expf(sG[i] - Gj);
                if (!isq) A2[i * 64 + (j & 7) * 8 + (j >> 3)] = (j < i) ? sB[i] * acc[jj] * dec : 0.f;
                else *(LAS bf16_t*)(Qs + i * 272 + j * 2) = (bf16_t)f2bf((j <= i) ? acc[jj] * dec : 0.f);
            }
        }
    }
    __syncthreads();
    { const int r = tid >> 3, ch = tid & 7; *(u32x4*)(QK + r * 64 + ch * 8) = *(const LAS u32x4*)(Qs + r * 272 + ch * 16); }
    for (int r2_ = 0; r2_ < 1 + ((SUBREP >> 9) & 1); ++r2_)
    {
        const int c = w * 8 + (lane >> 3), jg = lane & 7;
        float tt[8];
#pragma unroll
        for (int q = 0; q < 8; ++q) tt[q] = 0.f;
        f32x4 na0 = *(const LAS f32x4*)(A2 + jg * 8), na1 = *(const LAS f32x4*)(A2 + jg * 8 + 4);
#pragma unroll 1
        for (int i = 0; i < 64; ++i) {
            const f32x4 a0 = na0, a1 = na1;
            { const int i2 = (i + 1) & 63; na0 = *(const LAS f32x4*)(A2 + i2 * 64 + jg * 8); na1 = *(const LAS f32x4*)(A2 + i2 * 64 + jg * 8 + 4); }
            float part = (a0[0] * tt[0] + a0[1] * tt[1]) + (a0[2] * tt[2] + a0[3] * tt[3]) + ((a1[0] * tt[4] + a1[1] * tt[5]) + (a1[2] * tt[6] + a1[3] * tt[7]));
            part += __builtin_bit_cast(float, __builtin_amdgcn_update_dpp(0, __builtin_bit_cast(int, part), 0xB1, 0xF, 0xF, true));
            part += __builtin_bit_cast(float, __builtin_amdgcn_update_dpp(0, __builtin_bit_cast(int, part), 0x4E, 0xF, 0xF, true));
            part += __builtin_bit_cast(float, __builtin_amdgcn_update_dpp(0, __builtin_bit_cast(int, part), 0x141, 0xF, 0xF, true));
            const float tv = ((i == c) ? 1.0f : 0.0f) - part;
            const bool mine = jg == (i & 7); const int qi = i >> 3;
#pragma unroll
            for (int q = 0; q < 8; ++q) tt[q] = (mine && q == qi) ? tv : tt[q];
        }
#pragma unroll
        for (int q = 0; q < 8; ++q) *(LAS bf16_t*)(Ts + (jg + 8 * q) * 144 + c * 2) = (bf16_t)f2bf(tt[q]);
    }
    __syncthreads();
    {
        bf16x8 va[2], ka[2];
#pragma unroll
        for (int k2 = 0; k2 < 2; ++k2) {
            va[k2] = *(const LAS bf16x8*)(Vt + (w * 16 + fr) * 144 + (k2 * 32 + fq * 8) * 2);
            ka[k2] = *(const LAS bf16x8*)(KtW + (w * 16 + fr) * 144 + (k2 * 32 + fq * 8) * 2);
        }
#pragma unroll
        for (int jt = 0; jt < 4; ++jt) {
            f32x4 au = (f32x4){0.f, 0.f, 0.f, 0.f}, aw = (f32x4){0.f, 0.f, 0.f, 0.f};
#pragma unroll
            for (int k2 = 0; k2 < 2; ++k2) {
                const bf16x8 tf = *(const LAS bf16x8*)(Ts + (jt * 16 + fr) * 144 + (k2 * 32 + fq * 8) * 2);
                au = __builtin_amdgcn_mfma_f32_16x16x32_bf16(va[k2], tf, au, 0, 0, 0);
                aw = __builtin_amdgcn_mfma_f32_16x16x32_bf16(tf, ka[k2], aw, 0, 0, 0);
            }
            *(f32x4*)(UT + ((size_t)(w * 4 + jt) * 64 + lane) * 4) = au;
#pragma unroll
            for (int jj = 0; jj < 4; ++jj) *(LAS bf16_t*)(Ks + (jt * 16 + fq * 4 + jj) * 272 + (w * 16 + fr) * 2) = (bf16_t)f2bf(-aw[jj]);
        }
#pragma unroll
        for (int pp = 0; pp < 2; ++pp) {
            const int id = tid + pp * 512, r = id >> 3, ch = id & 7;
            *(u32x4*)(KDT + r * 64 + ch * 8) = *(const LAS u32x4*)(KdT + r * 144 + ch * 16);
        }
    }
    __syncthreads();
#pragma unroll
    for (int pp = 0; pp < 2; ++pp) { const int id = tid + pp * 512, r = id >> 4, ch = id & 15; *(u32x4*)(WN + r * 128 + ch * 8) = *(const LAS u32x4*)(Ks + r * 272 + ch * 16); }
    __syncthreads();
}

struct ScanFrags { bf16x8 wn[4]; bf16x8 qd[4]; bf16x8 qk[2]; bf16x8 kd[1][2]; f32x4 ut; float gl; };
__device__ __forceinline__ void scan_load(ScanFrags& f, PK p, int unit, int s, int w, int lane) {
    const int fr = lane & 15, fq = lane >> 4, et = w >> 2, xt = w & 3;
    const unsigned char* ws = p->ws;
    const bf16_t* WN = (const bf16_t*)(ws + WS_WN) + (size_t)unit * 8192;
    const bf16_t* QD = (const bf16_t*)(ws + WS_QD) + (size_t)unit * 8192;
    const bf16_t* KDT = (const bf16_t*)(ws + WS_KDT) + (size_t)unit * 8192;
    const bf16_t* QK = (const bf16_t*)(ws + WS_QK) + (size_t)unit * 4096;
    const float* UT = (const float*)(ws + WS_UT) + (size_t)unit * 8192;
#pragma unroll
    for (int k4 = 0; k4 < 4; ++k4) { f.wn[k4] = *(const bf16x8*)(WN + (xt * 16 + fr) * 128 + k4 * 32 + fq * 8); f.qd[k4] = *(const bf16x8*)(QD + (xt * 16 + fr) * 128 + k4 * 32 + fq * 8); }
#pragma unroll
    for (int k2 = 0; k2 < 2; ++k2) { f.qk[k2] = *(const bf16x8*)(QK + (xt * 16 + fr) * 64 + k2 * 32 + fq * 8); f.kd[0][k2] = *(const bf16x8*)(KDT + (w * 16 + fr) * 64 + k2 * 32 + fq * 8); }
    f.ut = *(const f32x4*)(UT + ((size_t)((s * 2 + et) * 4 + xt) * 64 + lane) * 4);
    { int z_ = 0; asm volatile("" : "+v"(z_)); f.gl = ((const float*)(ws + WS_GL))[unit + z_]; }
}
#define LBAR() do { asm volatile("s_waitcnt lgkmcnt(0)" ::: "memory"); __builtin_amdgcn_s_barrier(); asm volatile("" ::: "memory"); } while (0)
struct ScanState { f32x4 sacc[2]; };
__device__ __forceinline__ void scan_step(const ScanFrags& cur, ScanState& S, LAS unsigned char* St, LAS unsigned char* uT, float* ODF, int b, int h, int s, int n, int w, int lane) {
    const int fr = lane & 15, fq = lane >> 4, et = w >> 2, xt = w & 3;
    bf16x8 sa[4];
#pragma unroll
    for (int k4 = 0; k4 < 4; ++k4) sa[k4] = *(const LAS bf16x8*)(St + (et * 16 + fr) * 272 + (k4 * 32 + fq * 8) * 2);
    f32x4 u = cur.ut;
#pragma unroll
    for (int k4 = 0; k4 < 4; ++k4) u = __builtin_amdgcn_mfma_f32_16x16x32_bf16(sa[k4], cur.wn[k4], u, 0, 0, 0);
#pragma unroll
    for (int jj = 0; jj < 4; ++jj) *(LAS bf16_t*)(uT + (et * 16 + fq * 4 + jj) * 144 + (xt * 16 + fr) * 2) = (bf16_t)f2bf(u[jj]);
    f32x4 o = (f32x4){0.f, 0.f, 0.f, 0.f};
#pragma unroll
    for (int k4 = 0; k4 < 4; ++k4) o = __builtin_amdgcn_mfma_f32_16x16x32_bf16(sa[k4], cur.qd[k4], o, 0, 0, 0);
    LBAR();
    bf16x8 ua[2];
#pragma unroll
    for (int k2 = 0; k2 < 2; ++k2) ua[k2] = *(const LAS bf16x8*)(uT + (et * 16 + fr) * 144 + (k2 * 32 + fq * 8) * 2);
#pragma unroll
    for (int k2 = 0; k2 < 2; ++k2) o = __builtin_amdgcn_mfma_f32_16x16x32_bf16(ua[k2], cur.qk[k2], o, 0, 0, 0);
    *(f32x4*)(ODF + (size_t)(b * 2048 + n * 64 + xt * 16 + fr) * 512 + h * 128 + s * 32 + et * 16 + fq * 4) = o;
#pragma unroll
    for (int e2 = 0; e2 < 2; ++e2) {
        bf16x8 ue[2];
#pragma unroll
        for (int k2 = 0; k2 < 2; ++k2) ue[k2] = *(const LAS bf16x8*)(uT + (e2 * 16 + fr) * 144 + (k2 * 32 + fq * 8) * 2);
        f32x4 a = S.sacc[e2] * cur.gl;
#pragma unroll
        for (int k2 = 0; k2 < 2; ++k2) a = __builtin_amdgcn_mfma_f32_16x16x32_bf16(ue[k2], cur.kd[0][k2], a, 0, 0, 0);
        S.sacc[e2] = a;
    }
    LBAR();
#pragma unroll
    for (int e2 = 0; e2 < 2; ++e2)
#pragma unroll
        for (int jj = 0; jj < 4; ++jj) *(LAS bf16_t*)(St + (e2 * 16 + fq * 4 + jj) * 272 + (w * 16 + fr) * 2) = (bf16_t)f2bf(S.sacc[e2][jj]);
    LBAR();
}
__device__ __forceinline__ void dn_scan(const Ctx& C, int l, PK p) {
    if (C.bid >= 128) return;
    const int q_ = C.bid >> 3, s = q_ & 3, chain = (C.bid & 7) + 8 * (q_ >> 2), b = chain >> 2, h = chain & 3;
    const int w = C.wave, lane = C.lane, fr = lane & 15, fq = lane >> 4;
    LAS unsigned char* St = C.lds;
    LAS unsigned char* uT = C.lds + 8704;
    float* ODF = (float*)(p->ws + WS_ODF);
    ScanState S;
    S.sacc[0] = (f32x4){0.f, 0.f, 0.f, 0.f}; S.sacc[1] = (f32x4){0.f, 0.f, 0.f, 0.f};
    for (int i = C.tid; i < 8704 / 4; i += 512) ((LAS unsigned*)St)[i] = 0u;
    ScanFrags fa, fb, fc;
    const int u0 = (b * 32) * 4 + h;
    scan_load(fa, p, u0, s, w, lane);
    scan_load(fb, p, u0 + 4, s, w, lane);
    __syncthreads();
#pragma unroll 1
    for (int n = 0; n < 33; n += 3) {
        if (n + 2 < 32) scan_load(fc, p, u0 + (n + 2) * 4, s, w, lane);
        scan_step(fa, S, St, uT, ODF, b, h, s, n, w, lane);
        if (n + 3 < 32) scan_load(fa, p, u0 + (n + 3) * 4, s, w, lane);
        scan_step(fb, S, St, uT, ODF, b, h, s, n + 1, w, lane);
        if (n + 2 >= 32) break;
        if (n + 4 < 32) scan_load(fb, p, u0 + (n + 4) * 4, s, w, lane);
        scan_step(fc, S, St, uT, ODF, b, h, s, n + 2, w, lane);
    }
    float* So = p->out + O_DNP + ((size_t)(l * 8 + b) * 4 + h) * 16384;
#pragma unroll
    for (int e2 = 0; e2 < 2; ++e2)
#pragma unroll
        for (int jj = 0; jj < 4; ++jj) So[(size_t)(w * 16 + fr) * 128 + s * 32 + e2 * 16 + fq * 4 + jj] = S.sacc[e2][jj];
}

__device__ __forceinline__ void sample_merge(const Ctx& C, const bf16_t* wa, const bf16_t* wd, const bf16_t* OA, const bf16_t* OD, const bf16_t* P, bf16_t* MRG) {
    const int ct = C.bid, rt = C.wave, fr = C.lane & 15, fq = C.lane >> 4;
    const int lc = ct * 16 + fr, lg = lc & 31;
    const int phys = (lc & ~31) + ((lg >> 2) & 1) * 16 + (lg >> 3) * 4 + (lg & 3);
    const bf16_t* war = wa + (size_t)phys * 1024 + fq * 8; const bf16_t* wdr = wa + (size_t)phys * 1024 + 512 + fq * 8; (void)wd;
    const size_t trow = (size_t)TP + rt * 16 + fr;
    const bf16_t* xar = OA + trow * 1024 + fq * 8; const bf16_t* xdr = OA + trow * 1024 + 512 + fq * 8; (void)OD;
    f32x4 aa = (f32x4){0.f, 0.f, 0.f, 0.f}, ad = (f32x4){0.f, 0.f, 0.f, 0.f};
#pragma unroll 4
    for (int k = 0; k < 16; ++k) {
        const bf16x8 wfa = *(const bf16x8*)(war + k * 32), wfd = *(const bf16x8*)(wdr + k * 32);
        const bf16x8 xa = *(const bf16x8*)(xar + k * 32), xd = *(const bf16x8*)(xdr + k * 32);
        aa = __builtin_amdgcn_mfma_f32_16x16x32_bf16(wfa, xa, aa, 0, 0, 0);
        ad = __builtin_amdgcn_mfma_f32_16x16x32_bf16(wfd, xd, ad, 0, 0, 0);
    }
    const int col0 = ct * 16 + fq * 4;
    const u32x2 ga = *(const u32x2*)(P + trow * NIN + PC_GA + col0), gd = *(const u32x2*)(P + trow * NIN + PC_GD + col0);
    u32x2 w;
    w.x = pk2(sigmoidf_(bflo(ga.x)) * aa[0] + sigmoidf_(bflo(gd.x)) * ad[0], sigmoidf_(bfhi(ga.x)) * aa[1] + sigmoidf_(bfhi(gd.x)) * ad[1]);
    w.y = pk2(sigmoidf_(bflo(ga.y)) * aa[2] + sigmoidf_(bflo(gd.y)) * ad[2], sigmoidf_(bfhi(ga.y)) * aa[3] + sigmoidf_(bfhi(gd.y)) * ad[3]);
    *(u32x2*)(MRG + trow * DM + col0) = w;
}

#define XB_TMO      128
#define XB_XCNT(j)  (256  + 64 * (j))
#define XB_XSUB(j)  (1280 + 64 * (j))
#define XB_XGEN(j)  (2304 + 64 * (j))
#define XB_TOP      3328
#define XB_TOPGEN   3392
#define XCD_BAR_WORDS 3456
#define XB_SPIN_CAP (1u << 20)
__device__ __forceinline__ unsigned xb_ld(unsigned* p)              { return __hip_atomic_load(p, __ATOMIC_RELAXED, __HIP_MEMORY_SCOPE_AGENT); }
__device__ __forceinline__ unsigned xb_add(unsigned* p, unsigned v) { return __hip_atomic_fetch_add(p, v, __ATOMIC_RELAXED, __HIP_MEMORY_SCOPE_AGENT); }
__device__ __forceinline__ unsigned xb_xcc_id() { return (unsigned)__builtin_amdgcn_s_getreg((3 << 11) | 20) & 0xFu; }
#define XB_SPIN(cond, bar) do { unsigned _sp = 0; while (cond) { __builtin_amdgcn_s_sleep(1); \
    if ((++_sp & 255u) == 0u) { if (xb_ld(&(bar)[XB_TMO])) break; if (_sp > XB_SPIN_CAP) { atomicAdd(&(bar)[XB_TMO], 1u); break; } } } } while (0)
struct XcdBarrier { unsigned* bar; unsigned x; volatile LAS unsigned* st; };
__device__ __forceinline__ XcdBarrier xcd_barrier_post(unsigned* bar, volatile LAS unsigned* st) {
    XcdBarrier b; b.bar = bar; b.x = xb_xcc_id(); b.st = st;
    if (threadIdx.x == 0) (void)xb_add(&bar[XB_XCNT(b.x)], 1u);
    return b;
}
__device__ __forceinline__ void xcd_barrier_complete(unsigned* bar, unsigned x, unsigned& nloc, unsigned& nx) {
    const unsigned G = gridDim.x * gridDim.y * gridDim.z;
    unsigned sum, cnt, mine, sp = 0u;
    for (;;) {
        sum = 0u; cnt = 0u; mine = 0u;
#pragma unroll
        for (unsigned j = 0; j < 16; ++j) { const unsigned c = xb_ld(&bar[XB_XCNT(j)]); sum += c; cnt += (c > 0u) ? 1u : 0u; mine = (j == x) ? c : mine; }
        if (sum == G) break;
        __builtin_amdgcn_s_sleep(1);
        if ((++sp & 255u) == 0u) { if (xb_ld(&bar[XB_TMO])) break; if (sp > XB_SPIN_CAP) { atomicAdd(&bar[XB_TMO], 1u); break; } }
    }
    nloc = mine > 0u ? mine : 1u; nx = cnt > 0u ? cnt : 1u;
}
__device__ __forceinline__ void xcd_barrier(const XcdBarrier& b) {
    asm volatile("s_waitcnt vmcnt(0)" ::: "memory");
    __syncthreads();
    if (threadIdx.x == 0) {
        unsigned* bar = b.bar;
        __builtin_amdgcn_s_waitcnt(0);
        unsigned nloc = b.st[0], nx = b.st[1];
        if (nloc == 0u) { xcd_barrier_complete(bar, b.x, nloc, nx); b.st[0] = nloc; b.st[1] = nx; }
        const unsigned old = xb_add(&bar[XB_XSUB(b.x)], 1u);
        const unsigned gen = old / nloc;
        if (old + 1u == (gen + 1u) * nloc) {
            __builtin_amdgcn_fence(__ATOMIC_RELEASE, "agent");
            asm volatile("s_waitcnt vmcnt(0)" ::: "memory");
            const unsigned og = xb_add(&bar[XB_TOP], 1u);
            const unsigned tg = og / nx;
            if (og + 1u == (tg + 1u) * nx) xb_add(&bar[XB_TOPGEN], 1u);
            else XB_SPIN(xb_ld(&bar[XB_TOPGEN]) == tg, bar);
            __builtin_amdgcn_fence(__ATOMIC_ACQUIRE, "agent");
            xb_add(&bar[XB_XGEN(b.x)], 1u);
            asm volatile("s_waitcnt vmcnt(0)" ::: "memory");
        } else {
            XB_SPIN(xb_ld(&bar[XB_XGEN(b.x)]) == gen, bar);
            __builtin_amdgcn_fence(__ATOMIC_ACQUIRE, "agent");
            asm volatile("s_waitcnt vmcnt(0)" ::: "memory");
        }
    }
    __syncthreads();
}

#ifndef DISMASK
#define DISMASK 0
#endif
#define EN(x) (((DISMASK >> (x)) & 1) == 0)
#ifndef REPMASK
#define REPMASK 0
#endif
constexpr int NPH = 2 + 13 * DEPTH;
__global__ void __launch_bounds__(512, 2) fwd_megakernel(Params p_unused, int ph_lo, int ph_hi) {
    extern __shared__ __attribute__((aligned(16))) unsigned char lds_raw[];
    cg::grid_group grid = cg::this_grid();
    volatile LAS unsigned* MISC = (volatile LAS unsigned*)((LAS unsigned char*)lds_raw + LDS_BYTES - 64);
    if (threadIdx.x < 16) MISC[threadIdx.x] = 0u;
    __syncthreads();
    const XcdBarrier xbar = xcd_barrier_post((unsigned*)(((PK)__builtin_amdgcn_kernarg_segment_ptr())->ws + WS_BAR), MISC);
#pragma unroll 1
    for (int ph = ph_lo, rep = 0; ph < ph_hi;) {
        const __attribute__((address_space(4))) unsigned char* kp_ = (const __attribute__((address_space(4))) unsigned char*)__builtin_amdgcn_kernarg_segment_ptr();
        asm volatile("" : "+s"(kp_));
        PK p = (PK)kp_;
        unsigned char* ws = p->ws;
        int tid_ = threadIdx.x;
        asm volatile("" : "+v"(tid_));
        Ctx C; C.lds = (LAS unsigned char*)lds_raw; C.tid = tid_; C.lane = C.tid & 63; C.wave = __builtin_amdgcn_readfirstlane(C.tid >> 6); { int g_ = gridDim.x, b_ = blockIdx.x; asm volatile("" : "+s"(g_), "+s"(b_)); C.G = g_; C.bid = b_; }
        bf16_t* WB = (bf16_t*)(ws + WS_W);
        float* H = (float*)(ws + WS_H);
        bf16_t* XN = (bf16_t*)(ws + WS_XN);
        bf16_t* ACT = (bf16_t*)(ws + WS_ACT);
        float* TMP = (float*)(ws + WS_ACT);
        bf16_t* P = (bf16_t*)(ws + WS_P);
        bf16_t* OA = (bf16_t*)(ws + WS_OA);
        bf16_t* OD = (bf16_t*)(ws + WS_OA);
        float* BG = (float*)(ws + WS_BG);
        float2* ROPE = (float2*)(ws + WS_ROPE);
        float* YP = p->out + O_YP; float* YS = p->out + O_YS;
        if (ph == 0 && EN(13)) {
#pragma unroll 1
            for (int l = 0; l < DEPTH; ++l) {
                bf16_t* wl = WB + (size_t)l * WL_END;
                convert_weight(C, p->ffn1_gu + (size_t)l * DM * 5632, 5632, DM, 5632, 1, wl + WL_GU1);
                convert_weight(C, p->ffn1_dn + (size_t)l * FF * DM, DM, FF, DM, 0, wl + WL_DN1);
                convert_weight(C, p->w_in + (size_t)l * DM * NINSRC, NINSRC, DM, NIN, 2, wl + WL_WIN);
                convert_weight(C, p->w_attn_o + (size_t)l * 512 * DM, DM, 512, DM, 0, wl + WL_AO, 1024, 0);
                convert_weight(C, p->w_dn_o + (size_t)l * 512 * DM, DM, 512, DM, 0, wl + WL_AO, 1024, 512);
                convert_weight(C, p->w_out + (size_t)l * DM * DM, DM, DM, DM, 0, wl + WL_WO);
                convert_weight(C, p->ffn2_gu + (size_t)l * DM * 5632, 5632, DM, 5632, 1, wl + WL_GU2);
                convert_weight(C, p->ffn2_dn + (size_t)l * FF * DM, DM, FF, DM, 0, wl + WL_DN2);
            }
            for (int i = C.bid * 512 + C.tid; i < 2049 * 32; i += C.G * 512) {
                const int pi = i >> 5, fi = i & 31;
                const float inv = 1.0f / exp2f((float)fi * (13.287712379549449f / 32.0f));
                const float posf = pi < 2048 ? (float)pi : 8192.0f;
                const float angf = posf * inv;
                const double ang = (double)angf;
                const double r = ang - 6.283185307179586 * rint(ang * 0.15915494309189535);
                const float rf = (float)r;
                ROPE[i] = make_float2(__cosf(rf), __sinf(rf));
            }
        } else if (ph == NPH - 1) {
            const float* PART = (const float*)(ws + WS_PART); const float* HS = H + (size_t)TP * DM;
            for (int r = C.bid * 8 + C.wave; r < TS; r += C.G * 8) {
#pragma unroll
                for (int c = 0; c < 4; ++c) {
                    f32x4 a = (f32x4){0.f, 0.f, 0.f, 0.f};
                    for (int i = 0; i < 11; ++i) a += *(const f32x4*)(PART + ((size_t)i * TS + r) * DM + c * 256 + C.lane * 4);
                    *(f32x4*)(YS + (size_t)r * DM + c * 256 + C.lane * 4) = *(const f32x4*)(HS + (size_t)r * DM + c * 256 + C.lane * 4) + 0.5f * a;
                }
            }
        } else {
            const int l = (ph - 1) / 13, k = (ph - 1) % 13;
            const bf16_t* wl = WB + (size_t)l * WL_END;
            const float* XinP = l == 0 ? p->x_prompt : YP; const float* XinS = l == 0 ? p->x_sample : YS;
            float* HS = H + (size_t)TP * DM;
            float* PART = (float*)(ws + WS_PART);
            if (k == 0 && EN(0)) {
                norm_phase<false>(C, XinP, l == 0 ? XinS : HS, p->ffn1_norm + l * DM, XN, nullptr, nullptr, PART, l == 0 ? 0 : 11, 0.5f, YS);
            } else if ((k == 1 || k == 11) && EN(1)) {
                pg8::Gemm g{XN, wl + (k == 1 ? WL_GU1 : WL_GU2), MP, 5632, DM}; pg8::StaticOrder S; S.init(5632, DM, C.G, C.bid, 128, 22, 16); EpiSwiglu E{ACT}; pg8::gemm_phase(C.lds, g, S, E, C.tid);
            } else if ((k == 2 || k == 12 || k == 9) && EN(2)) {
                pg8::Gemm g{k == 9 ? XN : ACT, wl + (k == 2 ? WL_DN1 : (k == 12 ? WL_DN2 : WL_WO)), MP, DM, k == 9 ? DM : FF}; pg8::StaticOrder S; S.init(DM, k == 9 ? DM : FF, C.G, C.bid, 0, k == 9 ? 16 : 44, 4);
                EpiResid E{k == 2 ? XinP : H, k == 12 ? YP : H, k == 9 ? 1.0f : 0.5f, PART};
                pg8::gemm_phase(C.lds, g, S, E, C.tid);
            } else if (k == 3 && EN(3)) {
                norm_phase<true>(C, H, XinS, p->mix_norm + l * DM, XN, p->w_in + (size_t)l * DM * NINSRC, BG, PART, 11, 0.5f, HS);
            } else if (k == 4 && EN(4)) {
                pg8::Gemm g{XN, wl + WL_WIN, MP, NIN, DM}; pg8::StaticOrder S; S.init(NIN, DM, C.G, C.bid, 192, 19, 16);
                EpiWin E{P, p->q_norm + l * 64, p->k_norm + l * 64, ROPE};
                pg8::gemm_phase(C.lds, g, S, E, C.tid);
            } else if (k == 5 && EN(5)) {
                for (int r_ = 0; r_ < 1 + ((SUBREP >> 1) & 1); ++r_)
                for (int u = C.bid; u < 1024; u += C.G) dn_pre_unit(C, u, l, p, P, BG);
                __syncthreads();
                for (int r_ = 0; r_ < 1 + ((SUBREP >> 3) & 1); ++r_)
                for (int t = C.bid; t < 512; t += C.G) dn_sample_task(C, t, l, p, P, BG, OD);
                for (int i = C.bid * 512 + C.tid; i < 262144; i += C.G * 512) {
                    const int which = i >> 17, r = i & 131071, d = r & 63, kvh = (r >> 6) & 1, j = (r >> 7) & 127, b = r >> 14;
                    const size_t row = (size_t)b * 2048 + 1920 + j;
                    p->out[(which ? O_VP : O_KP) + (size_t)l * 131072 + r] = bf1(P[row * NIN + (which ? PC_V : PC_K) + kvh * 64 + d]);
                }
                for (int i = C.bid * 512 + C.tid; i < 36864; i += C.G * 512) {
                    const int c = i % 1536, j = (i / 1536) % 3, b = i / 4608;
                    const size_t row = (size_t)b * 2048 + 2045 + j;
                    p->out[O_CVP + (size_t)l * 36864 + i] = bf1(P[row * NIN + PC_RAW + c]);
                }
            } else if (k == 6 && EN(6)) {
                if (C.bid < 128 || C.G != 256) dn_scan(C, l, p);
                if (C.bid >= 128 || C.G != 256) {
                const int bid2 = C.G == 256 ? C.bid - 128 : C.bid, G2 = C.G == 256 ? 128 : C.G;
                for (int r_ = 0; r_ < 1 + ((SUBREP >> 0) & 1); ++r_)
                for (int u = bid2; u < 256; u += G2) attn_prompt_unit(C, u, P, p->sinks + l * 8, OA);
                for (int r_ = 0; r_ < 1 + ((SUBREP >> 2) & 1); ++r_)
                for (int t = bid2 * 8 + C.wave; t < 1024; t += G2 * 8) attn_sample_task(C, t, l, p, P, OA);
                }
            } else if (k == 7 && EN(7)) {
                if (C.bid < 64) sample_merge(C, wl + WL_AO, wl + WL_DO, OA, OD, P, XN);
                finalize_od(C, (const float*)(ws + WS_ODF), P, p->dn_out_norm + l * 128, OD);
            } else if (k == 8 && EN(8)) {
                pg8::Gemm g{OA, wl + WL_AO, MP, DM, 1024}; pg8::StaticOrder S; S.init(DM, 1024, C.G, C.bid, 0, 0, 16);
                EpiGateK E{P, XN};
                pg8::gemm_phase<EpiGateK, true>(C.lds, g, S, E, C.tid);
            } else if (k == 10 && EN(10)) {
                norm_phase<false>(C, H, HS, p->ffn2_norm + l * DM, XN, nullptr, nullptr, PART, 4, 1.0f, HS);
            }
        }
        { const int kk_ = ph == 0 ? 13 : (ph - 1) % 13;
          if (rep == 0 && ((REPMASK >> kk_) & 1)) { rep = 1; xcd_barrier(xbar); continue; } }
        rep = 0; ++ph;
        if (ph < ph_hi) { if (ph == 1) grid.sync(); else xcd_barrier(xbar); }
    }
}

extern "C" void kernel_launch(void* const* d_in, const int* in_sizes, int n_in, void* d_out, int out_size, void* d_ws, size_t ws_size, hipStream_t stream) {
    static int grid = 0;
    if (grid == 0) {
        if (n_in != 24 || ws_size < WS_END) { fprintf(stderr, "kernel_launch: unexpected n_in %d / ws_size %zu (need %zu)\n", n_in, ws_size, (size_t)WS_END); grid = -1; return; }
        int dev = 0, cus = 0, per_cu = 0;
        hipGetDevice(&dev);
        hipDeviceGetAttribute(&cus, hipDeviceAttributeMultiprocessorCount, dev);
        if (hipFuncSetAttribute((const void*)fwd_megakernel, hipFuncAttributeMaxDynamicSharedMemorySize, LDS_BYTES) != hipSuccess) { fprintf(stderr, "hipFuncSetAttribute failed\n"); grid = -1; return; }
        hipOccupancyMaxActiveBlocksPerMultiprocessor(&per_cu, (const void*)fwd_megakernel, 512, LDS_BYTES);
        (void)hipGetLastError();
        if (per_cu < 1) per_cu = 1;
        grid = cus;
    }
    if (grid < 0) return;
    if (hipMemsetAsync((char*)d_ws + WS_BAR, 0, 16384, stream) != hipSuccess) { fprintf(stderr, "memset failed\n"); return; }
    Params p{};
    const float* const* in = (const float* const*)d_in;
    p.x_prompt = in[0]; p.x_sample = in[1]; p.cache_k = in[2]; p.cache_v = in[3]; p.state_dn = in[4]; p.state_conv = in[5];
    p.ffn1_norm = in[6]; p.ffn1_gu = in[7]; p.ffn1_dn = in[8]; p.mix_norm = in[9]; p.w_in = in[10]; p.q_norm = in[11]; p.k_norm = in[12];
    p.sinks = in[13]; p.conv_w = in[14]; p.A_log = in[15]; p.dt_bias = in[16]; p.dn_out_norm = in[17]; p.w_attn_o = in[18]; p.w_dn_o = in[19];
    p.w_out = in[20]; p.ffn2_norm = in[21]; p.ffn2_gu = in[22]; p.ffn2_dn = in[23];
    p.out = (float*)d_out; p.ws = (unsigned char*)d_ws;
    int ph_lo = 0, ph_hi = NPH;
    void* args[] = {&p, &ph_lo, &ph_hi};
    hipError_t e = hipLaunchCooperativeKernel((const void*)fwd_megakernel, dim3(grid), dim3(512), args, LDS_BYTES, stream);
    if (e != hipSuccess) fprintf(stderr, "cooperative launch failed: %s (grid %d)\n", hipGetErrorString(e), grid);
}
```
